# Optimizing an MI355X kernel written in HIP

```python
import math
import jax, jax.numpy as jnp
from jax import lax
import numpy as np

D_MODEL = 1024
BATCH = 16
SEQ = 4096
DEPTH = 2
DEC_BATCH = 32
DEC_SEQ = 16
PAST_LEN = 2048

CHUNK = 64
D_SSM = D_MODEL // 2
SSM_CH = 16
SSM_GROUPS = D_SSM // SSM_CH
SSM_STATE = 64
D_ATTN = D_MODEL - D_SSM
HEAD_DIM = 64
N_HEADS = D_ATTN // HEAD_DIM
PAST_CHUNKS = 8
BAND = PAST_CHUNKS + 1
REL_CLIP = 128
N_REL = 2 * REL_CLIP + 1
EPS = 1e-6
NEG_INF = -1e30
DT_MIN = 1e-3
DT_MAX = 1e-1
SPLITS = [D_SSM, 2 * D_SSM, 2 * D_SSM + D_ATTN, 2 * D_SSM + 2 * D_ATTN, 2 * D_SSM + 3 * D_ATTN]
D_IN = 2 * D_SSM + 4 * D_ATTN

kernel_name = "hymba_s5_chunkband_stream_step"


def _rms_norm(x, gain):
    xf = x.astype(jnp.float32)
    y = xf * lax.rsqrt(jnp.mean(xf * xf, axis=-1, keepdims=True) + EPS)
    return (y * gain.astype(jnp.float32)).astype(x.dtype)


def _cmul(xr, xi, yr, yi):
    return xr * yr - xi * yi, xr * yi + xi * yr


def _s5_discretize(a_re, a_im, b_re, b_im, log_dt):
    f32 = jnp.float32
    a_re = a_re.astype(f32)
    a_im = a_im.astype(f32)
    dt = jnp.exp(log_dt.astype(f32))[:, None]
    mag = jnp.exp(dt * a_re)
    ab_re = mag * jnp.cos(dt * a_im)
    ab_im = mag * jnp.sin(dt * a_im)
    den = a_re * a_re + a_im * a_im
    nr = ab_re - 1.0
    f_re = (nr * a_re + ab_im * a_im) / den
    f_im = (ab_im * a_re - nr * a_im) / den
    bb_re, bb_im = _cmul(f_re[..., None], f_im[..., None], b_re.astype(f32), b_im.astype(f32))
    return ab_re, ab_im, bb_re, bb_im


def _scan_combine(left, right):
    ar1, ai1, br1, bi1 = left
    ar2, ai2, br2, bi2 = right
    ar, ai = _cmul(ar2, ai2, ar1, ai1)
    pr, pi = _cmul(ar2, ai2, br1, bi1)
    return ar, ai, pr + br2, pi + bi2


def _s5_branch(u, a_re, a_im, b_re, b_im, c_re, c_im, d, log_dt, w_glu, h0_re, h0_im):
    f32 = jnp.float32
    bsz, length, _ = u.shape
    uf = u.astype(f32).reshape(bsz, length, SSM_GROUPS, SSM_CH)
    ab_re, ab_im, bb_re, bb_im = _s5_discretize(a_re, a_im, b_re, b_im, log_dt)
    bu_re = jnp.einsum('blgh,gph->lbgp', uf, bb_re)
    bu_im = jnp.einsum('blgh,gph->lbgp', uf, bb_im)
    if h0_re is not None:
        cr, ci = _cmul(ab_re, ab_im, h0_re.astype(f32), h0_im.astype(f32))
        bu_re = bu_re.at[0].add(cr)
        bu_im = bu_im.at[0].add(ci)
    a_re_t = jnp.broadcast_to(ab_re, (length, 1, SSM_GROUPS, SSM_STATE))
    a_im_t = jnp.broadcast_to(ab_im, (length, 1, SSM_GROUPS, SSM_STATE))
    _, _, h_re, h_im = lax.associative_scan(_scan_combine, (a_re_t, a_im_t, bu_re, bu_im), axis=0)
    y = (jnp.einsum('lbgp,ghp->blgh', h_re, c_re.astype(f32))
         - jnp.einsum('lbgp,ghp->blgh', h_im, c_im.astype(f32))
         + d.astype(f32) * uf)
    y = jax.nn.gelu(y.reshape(bsz, length, D_SSM)).astype(u.dtype)
    z_val, z_gate = jnp.split(jnp.einsum('ble,ef->blf', y, w_glu), 2, axis=-1)
    out = z_val * jax.nn.sigmoid(z_gate)
    return out, h_re[-1].astype(u.dtype), h_im[-1].astype(u.dtype)


def _rel_bias(rel_table, dist):
    idx = jnp.clip(dist, -REL_CLIP, REL_CLIP) + REL_CLIP
    return rel_table.astype(jnp.float32)[:, idx]


def _band_attention(q, k, v, rel_table):
    bsz, length = q.shape[:2]
    nc = length // CHUNK

    def chunks(t):
        return t.reshape(bsz, nc, CHUNK, N_HEADS, HEAD_DIM)

    pad = ((0, 0), (PAST_CHUNKS, 0), (0, 0), (0, 0), (0, 0))
    kp = jnp.pad(chunks(k), pad)
    vp = jnp.pad(chunks(v), pad)
    kb = jnp.concatenate([kp[:, j:j + nc] for j in range(BAND)], axis=2)
    vb = jnp.concatenate([vp[:, j:j + nc] for j in range(BAND)], axis=2)
    s = jnp.einsum('bnqhd,bnkhd->bnhqk', chunks(q), kb).astype(jnp.float32) * (HEAD_DIM ** -0.5)
    dist = jnp.arange(CHUNK)[:, None] + PAST_CHUNKS * CHUNK - jnp.arange(BAND * CHUNK)[None, :]
    bias = _rel_bias(rel_table, dist)
    valid = (jnp.arange(nc)[:, None] - PAST_CHUNKS + jnp.arange(BAND)[None, :]) >= 0
    valid = jnp.repeat(valid, CHUNK, axis=1)
    s = jnp.where(valid[None, :, None, None, :], s + bias[None, None], NEG_INF)
    p = jax.nn.softmax(s, axis=-1).astype(v.dtype)
    o = jnp.einsum('bnhqk,bnkhd->bnqhd', p, vb)
    return o.reshape(bsz, length, D_ATTN)


def _cached_attention(q, k, v, k_cache, v_cache, rel_table):
    bsz, length = q.shape[:2]
    rows = k_cache.shape[1]
    keys = jnp.concatenate([k_cache.astype(k.dtype), k], axis=1)
    vals = jnp.concatenate([v_cache.astype(v.dtype), v], axis=1)
    s = jnp.einsum('bqhd,bkhd->bhqk', q, keys).astype(jnp.float32) * (HEAD_DIM ** -0.5)
    dist = jnp.arange(length)[:, None] + rows - jnp.arange(rows + length)[None, :]
    s = s + _rel_bias(rel_table, dist)[None]
    p = jax.nn.softmax(s, axis=-1).astype(v.dtype)
    o = jnp.einsum('bhqk,bkhd->bqhd', p, vals)
    return o.reshape(bsz, length, D_ATTN)


def _layer(x, norm_gain, w_in, a_re, a_im, b_re, b_im, c_re, c_im, d, log_dt, w_glu,
           q_gain, k_gain, rel_table, w_out, k_cache, v_cache, h0_re, h0_im):
    bsz, length, _ = x.shape
    h = _rms_norm(x, norm_gain)
    z = jnp.einsum('bld,de->ble', h, w_in)
    u, g_s, q, k, v, g_a = jnp.split(z, SPLITS, axis=-1)
    y_s, hr, hi = _s5_branch(u, a_re, a_im, b_re, b_im, c_re, c_im, d, log_dt, w_glu, h0_re, h0_im)

    def heads(t):
        return t.reshape(bsz, length, N_HEADS, HEAD_DIM)

    q = _rms_norm(heads(q), q_gain)
    k = _rms_norm(heads(k), k_gain)
    v = heads(v)
    if k_cache is None:
        y_a = _band_attention(q, k, v, rel_table)
        rows = min(PAST_CHUNKS * CHUNK, length)
        new_k = k[:, length - rows:]
        new_v = v[:, length - rows:]
    else:
        y_a = _cached_attention(q, k, v, k_cache, v_cache, rel_table)
        new_k = k
        new_v = v
    mixed = jnp.concatenate([y_s * jax.nn.silu(g_s), y_a * jax.nn.silu(g_a)], axis=-1)
    y = x + jnp.einsum('ble,ed->bld', mixed, w_out)
    return y, new_k, new_v, hr, hi


def setup_inputs(seed: int = 0) -> dict:
    key = jax.random.key(seed)
    ks = jax.random.split(key, 24)
    f32 = jnp.float32
    kv_rows = min(PAST_CHUNKS * CHUNK, PAST_LEN)
    nrm = lambda k, shp: jax.random.normal(k, shp, f32)
    a_im_base = math.pi * jnp.arange(SSM_STATE, dtype=f32)
    return {
        "x_prompt": nrm(ks[0], (BATCH, SEQ, D_MODEL)),
        "x_sample": nrm(ks[1], (DEC_BATCH, DEC_SEQ, D_MODEL)),
        "cache_k": nrm(ks[2], (DEPTH, DEC_BATCH, kv_rows, N_HEADS, HEAD_DIM)),
        "cache_v": nrm(ks[3], (DEPTH, DEC_BATCH, kv_rows, N_HEADS, HEAD_DIM)),
        "state_ssm_re": 0.1 * nrm(ks[4], (DEPTH, DEC_BATCH, SSM_GROUPS, SSM_STATE)),
        "state_ssm_im": 0.1 * nrm(ks[5], (DEPTH, DEC_BATCH, SSM_GROUPS, SSM_STATE)),
        "norm_gain": 1.0 + 0.05 * nrm(ks[6], (DEPTH, D_MODEL)),
        "w_in": nrm(ks[7], (DEPTH, D_MODEL, D_IN)) * D_MODEL ** -0.5,
        "ssm_a_re": -0.5 + 0.01 * nrm(ks[8], (DEPTH, SSM_GROUPS, SSM_STATE)),
        "ssm_a_im": a_im_base + 0.01 * nrm(ks[9], (DEPTH, SSM_GROUPS, SSM_STATE)),
        "ssm_b_re": nrm(ks[10], (DEPTH, SSM_GROUPS, SSM_STATE, SSM_CH)) * (2 * SSM_CH) ** -0.5,
        "ssm_b_im": nrm(ks[11], (DEPTH, SSM_GROUPS, SSM_STATE, SSM_CH)) * (2 * SSM_CH) ** -0.5,
        "ssm_c_re": nrm(ks[12], (DEPTH, SSM_GROUPS, SSM_CH, SSM_STATE)) * SSM_STATE ** -0.5,
        "ssm_c_im": nrm(ks[13], (DEPTH, SSM_GROUPS, SSM_CH, SSM_STATE)) * SSM_STATE ** -0.5,
        "ssm_d": nrm(ks[14], (DEPTH, SSM_GROUPS, SSM_CH)),
        "ssm_log_dt": jax.random.uniform(ks[15], (DEPTH, SSM_GROUPS), f32, math.log(DT_MIN), math.log(DT_MAX)),
        "w_glu": nrm(ks[16], (DEPTH, D_SSM, 2 * D_SSM)) * D_SSM ** -0.5,
        "q_norm_gain": 1.0 + 0.05 * nrm(ks[17], (DEPTH, HEAD_DIM)),
        "k_norm_gain": 1.0 + 0.05 * nrm(ks[18], (DEPTH, HEAD_DIM)),
        "rel_bias": 0.1 * nrm(ks[19], (DEPTH, N_HEADS, N_REL)),
        "w_out": nrm(ks[20], (DEPTH, D_MODEL, D_MODEL)) * D_MODEL ** -0.5,
    }


def reference(x_prompt, x_sample, cache_k, cache_v, state_ssm_re, state_ssm_im, norm_gain, w_in,
              ssm_a_re, ssm_a_im, ssm_b_re, ssm_b_im, ssm_c_re, ssm_c_im, ssm_d, ssm_log_dt,
              w_glu, q_norm_gain, k_norm_gain, rel_bias, w_out):
    yp = x_prompt
    ys = x_sample
    pk, pv, pr, pi, sk, sv, sr, si = [], [], [], [], [], [], [], []
    for l in range(DEPTH):
        w = (norm_gain[l], w_in[l], ssm_a_re[l], ssm_a_im[l], ssm_b_re[l], ssm_b_im[l],
             ssm_c_re[l], ssm_c_im[l], ssm_d[l], ssm_log_dt[l], w_glu[l],
             q_norm_gain[l], k_norm_gain[l], rel_bias[l], w_out[l])
        yp, k_p, v_p, r_p, i_p = _layer(yp, *w, None, None, None, None)
        ys, k_s, v_s, r_s, i_s = _layer(ys, *w, cache_k[l], cache_v[l], state_ssm_re[l], state_ssm_im[l])
        pk.append(k_p); pv.append(v_p); pr.append(r_p); pi.append(i_p)
        sk.append(k_s); sv.append(v_s); sr.append(r_s); si.append(i_s)
    return (yp, ys, jnp.stack(pk), jnp.stack(pv), jnp.stack(pr), jnp.stack(pi),
            jnp.stack(sk), jnp.stack(sv), jnp.stack(sr), jnp.stack(si))
```

```cpp
#include <hip/hip_runtime.h>
#include <hip/hip_cooperative_groups.h>
#include <cstdio>
#include <cstdint>
#include <cmath>
namespace cg = cooperative_groups;

#define LAS __attribute__((address_space(3)))
#define GAS __attribute__((address_space(1)))
typedef unsigned short bf16_t;
typedef short bf16x8 __attribute__((ext_vector_type(8)));
typedef short s16x4 __attribute__((ext_vector_type(4)));
typedef float f32x2 __attribute__((ext_vector_type(2)));
typedef float f32x4 __attribute__((ext_vector_type(4)));
typedef float f32x16 __attribute__((ext_vector_type(16)));
typedef unsigned u32x2 __attribute__((ext_vector_type(2)));
typedef unsigned u32x4 __attribute__((ext_vector_type(4)));

constexpr int DM = 1024, NB = 16, SEQ = 4096, NL = 2, SBAT = 32, SSEQ = 16, PAST = 512;
constexpr int MP = NB * SEQ, MS = SBAT * SSEQ, MT = MP + MS;
constexpr int DS = 512, NG = 32, NP = 64, NCHN = 16, NH = 8, HD = 64, DIN = 3072, NREL = 257;
constexpr int NCH = SEQ / 64;
constexpr float EPS = 1e-6f;
constexpr float LOG2E = 1.4426950408889634f;
constexpr float QSCALE = 0.125f * LOG2E;

constexpr size_t O_YP = 0, O_YS = 67108864, O_KP = 67633152, O_VP = 76021760, O_RP = 84410368, O_IP = 84475904,
                 O_KS = 84541440, O_VS = 85065728, O_RS = 85590016, O_IS = 85721088, O_END = 85852160;

constexpr size_t MiB = 1u << 20;
constexpr size_t WS_CTL = 0, CTL_BYTES = 1 * MiB;
constexpr size_t WS_WIN = 1 * MiB, WIN_L = 6 * MiB;
constexpr size_t WS_WGLU = 13 * MiB, WGLU_L = 1 * MiB;
constexpr size_t WS_WOUT = 15 * MiB, WOUT_L = 2 * MiB;
constexpr size_t WS_TAB = 19 * MiB, TAB_L = 2 * MiB;
constexpr size_t WS_PM = 24 * MiB, PM_L = 16 * MiB;
constexpr size_t WS_ROWSS = 56 * MiB;
constexpr size_t WS_HIN = 61 * MiB;
constexpr size_t WS_XB = 77 * MiB;
constexpr size_t ACT_STRIDE = 65 * MiB;
constexpr size_t WS_U = 206 * MiB, WS_SG = WS_U + ACT_STRIDE, WS_Q = WS_SG + ACT_STRIDE, WS_K = WS_Q + ACT_STRIDE, WS_V = WS_K + ACT_STRIDE,
                 WS_SGA = WS_V + ACT_STRIDE, WS_YG = WS_SGA + ACT_STRIDE, WS_MIX = WS_YG + ACT_STRIDE, WS_END = WS_MIX + 129 * MiB;
static_assert(WS_END <= 1024 * MiB, "workspace");
constexpr size_t T_AB = 0, T_A64 = 16384, T_BU = 32768, T_D = T_BU + 262144, T_C = T_D + 32768, T_BIAS = T_C + 131072, T_END = T_BIAS + 524288;
static_assert(T_END <= TAB_L, "tables");
constexpr int CW_QUEUE = 1024;
constexpr int CW_BAR = 8192;

__device__ __forceinline__ unsigned f2bf(float f) { unsigned u = __builtin_bit_cast(unsigned, f); return (u + 0x7fffu + ((u >> 16) & 1u)) >> 16; }
__device__ __forceinline__ float bf2f(unsigned h) { return __builtin_bit_cast(float, h << 16); }
__device__ __forceinline__ unsigned pk2(float lo, float hi) { return f2bf(lo) | (f2bf(hi) << 16); }
__device__ __forceinline__ float silu_f(float x) { return x / (1.0f + __expf(-x)); }
__device__ __forceinline__ float sigmoid_f(float x) { return 1.0f / (1.0f + __expf(-x)); }
__device__ __forceinline__ float gelu_tanh(float x) { const float u = 0.7978845608028654f * (x + 0.044715f * x * x * x); const float e = __expf(2.0f * u); const float t = 1.0f - 2.0f / (e + 1.0f); return 0.5f * x * (1.0f + t); }
namespace pg8 {
#define PG8_LAS __attribute__((address_space(3)))
constexpr int BM = 256, BK = 64, HALF = 128, HTB = HALF * BK * 2  , STAGE_BYTES = 8 * HTB, NXCD = 8, WGM = 8;

__host__ __device__ __forceinline__ int lds_byte(int r, int c) { const int st = (r >> 4) * 2 + (c >> 5), rr = r & 15, cc = c & 31, ob = rr * 64 + cc * 2; return st * 1024 + (ob ^ (((ob >> 9) & 1) << 5)); }
__host__ __device__ __forceinline__ void stage_rc(int b, int& R, int& C) { const int st = b / 1024, sb = b % 1024, swz = sb ^ (((sb >> 9) & 1) << 5); R = (st >> 1) * 16 + swz / 64; C = (st & 1) * 32 + (swz % 64) / 2; }
__host__ __device__ __forceinline__ int perm32(int rho) { const int n = rho >> 4, i = rho & 15; return 8 * (i >> 2) + 4 * n + (i & 3); }

struct Unit { int pm, pn; };

struct GemmStd {
    const char* A; const char* Bt; int K;
    __device__ __forceinline__ const char* a_base(const Unit& u) const { return A + (size_t)u.pm * BM * K * 2; }
    __device__ __forceinline__ const char* b_base(const Unit& u) const { return Bt + (size_t)u.pn * BM * K * 2; }
    __device__ __forceinline__ unsigned a_voff(int R, int C) const { return (unsigned)(R * K + C) * 2u; }
    __device__ __forceinline__ unsigned b_voff(int R, int C) const { return (unsigned)(R * K + C) * 2u; }
    __device__ __forceinline__ size_t a_kstep() const { return BK * 2; }
    __device__ __forceinline__ size_t b_kstep() const { return BK * 2; }
    __device__ __forceinline__ size_t a_hstep() const { return (size_t)HALF * K * 2; }
    __device__ __forceinline__ size_t b_hstep() const { return (size_t)HALF * K * 2; }
    __device__ __forceinline__ int nt() const { return K / BK; }
};
struct GemmPassA {
    const char* U; const char* PM;
    __device__ __forceinline__ const char* a_base(const Unit& u) const { return U + (size_t)(u.pm >> 2) * 32 + (size_t)(u.pm & 3) * 256 * 65536; }
    __device__ __forceinline__ const char* b_base(const Unit& u) const { return PM + (size_t)(u.pm >> 2) * (256 * 1024 * 2); }
    __device__ __forceinline__ unsigned a_voff(int R, int C) const { return (unsigned)R * 65536u + (unsigned)(C >> 4) * 1024u + (unsigned)(C & 15) * 2u; }
    __device__ __forceinline__ unsigned b_voff(int R, int C) const { return (unsigned)(R * 1024 + C) * 2u; }
    __device__ __forceinline__ size_t a_kstep() const { return 4096; }
    __device__ __forceinline__ size_t b_kstep() const { return BK * 2; }
    __device__ __forceinline__ size_t a_hstep() const { return (size_t)HALF * 65536; }
    __device__ __forceinline__ size_t b_hstep() const { return (size_t)HALF * 1024 * 2; }
    __device__ __forceinline__ int nt() const { return 16; }
};

struct StaticOrder {
    int nM, nN, nwg, G, c;
    __host__ __device__ void init(int M, int N, int G_, int c_) { nM = M / BM; nN = N / BM; nwg = nM * nN; G = G_; c = c_; }
    __host__ __device__ bool next(int i, Unit& u) const {
        const long L = (long)i * G + c; if (L >= nwg) return false;
        int wgid = (int)L; { const int q = nwg / NXCD, r = nwg % NXCD, xcd = wgid % NXCD, off = wgid / NXCD; wgid = (xcd < r ? xcd * (q + 1) : r * (q + 1) + (xcd - r) * q) + off; }
        const int nig = WGM * nN, gid = wgid / nig, fm = gid * WGM, gsz = (nM - fm) < WGM ? (nM - fm) : WGM;
        u.pm = fm + ((wgid % nig) % gsz); u.pn = (wgid % nig) / gsz; return true;
    }
    __device__ __forceinline__ void a_ready(const Unit&) const {}
    __device__ __forceinline__ void done(const Unit&) const {}
};
struct OneUnitOrder {
    int n, c;
    __device__ __forceinline__ bool next(int i, Unit& u) const { if (i != 0 || c >= n) return false; u.pm = c; u.pn = 0; return true; }
    __device__ __forceinline__ void a_ready(const Unit&) const {}
    __device__ __forceinline__ void done(const Unit&) const {}
};


struct EpiInProj {
    static constexpr bool PERM = false, AFTER_DRAIN = false;
    const float* rowss; unsigned char* ws; const float* qg; const float* kg; float* out; int layer;
    __device__ __forceinline__ void operator()(const f32x4 (&acc)[2][2][4][2], const Unit& u, int wr, int wc, int fr, int fq) const {
        const int kind = u.pn >> 1;
        bf16_t* dst = (bf16_t*)(ws + WS_U + (size_t)kind * ACT_STRIDE);
        const int colb = (u.pn & 1) * 256 + wc * 64 + fq * 16;
        float gv[16];
#pragma unroll
        for (int e = 0; e < 16; ++e) gv[e] = 1.f;
        if (kind == 2 || kind == 3) { const float* gp = (kind == 2 ? qg : kg) + fq * 16;
#pragma unroll
            for (int e4 = 0; e4 < 4; ++e4) { const f32x4 t = *(const GAS f32x4*)(gp + 4 * e4); gv[4 * e4] = t.x; gv[4 * e4 + 1] = t.y; gv[4 * e4 + 2] = t.z; gv[4 * e4 + 3] = t.w; }
            if (kind == 2) {
#pragma unroll
                for (int e = 0; e < 16; ++e) gv[e] *= QSCALE; } }
        const bool want_out = (kind == 3 || kind == 4) && (u.pm >= 256 || (u.pm & 15) >= 14);
        float* ob = out + (kind == 3 ? (u.pm >= 256 ? O_KS : O_KP) : (u.pm >= 256 ? O_VS : O_VP));
#pragma unroll
        for (int ai = 0; ai < 2; ++ai)
#pragma unroll
            for (int m = 0; m < 4; ++m) {
                const int row = u.pm * BM + ai * HALF + wr * 64 + m * 16 + fr;
                const f32x4 pr = *(const GAS f32x4*)(rowss + (size_t)row * 16 + fq * 4);
                float ss = (pr.x + pr.y) + (pr.z + pr.w); ss += __shfl_xor(ss, 16); ss += __shfl_xor(ss, 32);
                const float rstd = rsqrtf(ss * (1.0f / 1024.0f) + EPS);
                float v[16];
#pragma unroll
                for (int bj = 0; bj < 2; ++bj)
#pragma unroll
                    for (int n = 0; n < 2; ++n)
#pragma unroll
                        for (int i = 0; i < 4; ++i) v[8 * bj + 4 * n + i] = acc[ai][bj][m][n][i] * rstd;
                if (kind == 1 || kind == 5) {
#pragma unroll
                    for (int e = 0; e < 16; ++e) v[e] = silu_f(v[e]);
                } else if (kind == 2 || kind == 3) {
                    float q = 0.f;
#pragma unroll
                    for (int e = 0; e < 16; ++e) q += v[e] * v[e];
                    q += __shfl_xor(q, 16); q += __shfl_xor(q, 32);
                    const float r = rsqrtf(q * (1.0f / 64.0f) + EPS);
#pragma unroll
                    for (int e = 0; e < 16; ++e) v[e] = v[e] * r * gv[e];
                }
                u32x4 w0, w1;
                w0.x = pk2(v[0], v[1]); w0.y = pk2(v[2], v[3]); w0.z = pk2(v[4], v[5]); w0.w = pk2(v[6], v[7]);
                w1.x = pk2(v[8], v[9]); w1.y = pk2(v[10], v[11]); w1.z = pk2(v[12], v[13]); w1.w = pk2(v[14], v[15]);
                bf16_t* dp = dst + (size_t)row * 512 + colb;
                *(GAS u32x4*)dp = w0; *(GAS u32x4*)(dp + 8) = w1;
                if (want_out) {
                    long orow = -1;
                    if (row >= MP) orow = (long)layer * MS + (row - MP);
                    else { const int t = row & (SEQ - 1); if (t >= SEQ - PAST) orow = ((long)layer * NB + (row >> 12)) * PAST + (t - (SEQ - PAST)); }
                    if (orow >= 0) { float* op = ob + orow * 512 + colb;
                        float vo[16];
#pragma unroll
                        for (int e = 0; e < 16; ++e) vo[e] = (kind == 3) ? v[e] : v[e];
#pragma unroll
                        for (int e4 = 0; e4 < 4; ++e4) *(GAS f32x4*)(op + 4 * e4) = (f32x4){vo[4 * e4], vo[4 * e4 + 1], vo[4 * e4 + 2], vo[4 * e4 + 3]}; }
                }
            }
    }
};

struct EpiGlu {
    static constexpr bool PERM = false, AFTER_DRAIN = false;
    const bf16_t* SG; bf16_t* MIX;
    __device__ __forceinline__ void operator()(const f32x4 (&acc)[2][2][4][2], const Unit& u, int wr, int wc, int fr, int fq) const {
        const int col = u.pn * 128 + wc * 32 + fq * 8;
#pragma unroll
        for (int ai = 0; ai < 2; ++ai)
#pragma unroll
            for (int m = 0; m < 4; ++m) {
                const int row = u.pm * BM + ai * HALF + wr * 64 + m * 16 + fr;
                const u32x4 sg = *(const GAS u32x4*)(SG + (size_t)row * 512 + col);
                float o[8];
#pragma unroll
                for (int n = 0; n < 2; ++n)
#pragma unroll
                    for (int i = 0; i < 4; ++i) { const int e = 4 * n + i; const unsigned sw = sg[e >> 1]; const float s = bf2f((e & 1) ? (sw >> 16) : (sw & 0xffffu));
                        o[e] = acc[ai][0][m][n][i] * sigmoid_f(acc[ai][1][m][n][i]) * s; }
                u32x4 w; w.x = pk2(o[0], o[1]); w.y = pk2(o[2], o[3]); w.z = pk2(o[4], o[5]); w.w = pk2(o[6], o[7]);
                *(GAS u32x4*)(MIX + (size_t)row * 1024 + col) = w;
            }
    }
};

struct EpiOut {
    static constexpr bool PERM = false, AFTER_DRAIN = false;
    const float* resP; const float* resS; float* outP; float* outS; bf16_t* XB; float* rowss; int first;
    __device__ __forceinline__ void operator()(const f32x4 (&acc)[2][2][4][2], const Unit& u, int wr, int wc, int fr, int fq) const {
        const int col = u.pn * 256 + wc * 64 + fq * 16;
#pragma unroll
        for (int ai = 0; ai < 2; ++ai)
#pragma unroll
            for (int m = 0; m < 4; ++m) {
                const int row = u.pm * BM + ai * HALF + wr * 64 + m * 16 + fr;
                const float* rp = (row < MP) ? resP + (size_t)row * DM + col : resS + (size_t)(row - MP) * DM + col;
                float* op = (row < MP) ? outP + (size_t)row * DM + col : outS + (size_t)(row - MP) * DM + col;
                float y[16]; float ss = 0.f;
#pragma unroll
                for (int bj = 0; bj < 2; ++bj)
#pragma unroll
                    for (int n = 0; n < 2; ++n) { const f32x4 r = *(const GAS f32x4*)(rp + 8 * bj + 4 * n); const f32x4 t = r + acc[ai][bj][m][n];
                        *(GAS f32x4*)(op + 8 * bj + 4 * n) = t;
                        y[8 * bj + 4 * n] = t.x; y[8 * bj + 4 * n + 1] = t.y; y[8 * bj + 4 * n + 2] = t.z; y[8 * bj + 4 * n + 3] = t.w; }
                if (first) {
#pragma unroll
                    for (int e = 0; e < 16; ++e) ss += y[e] * y[e];
                    ss += __shfl_xor(ss, 16); ss += __shfl_xor(ss, 32);
                    u32x4 w0, w1;
                    w0.x = pk2(y[0], y[1]); w0.y = pk2(y[2], y[3]); w0.z = pk2(y[4], y[5]); w0.w = pk2(y[6], y[7]);
                    w1.x = pk2(y[8], y[9]); w1.y = pk2(y[10], y[11]); w1.z = pk2(y[12], y[13]); w1.w = pk2(y[14], y[15]);
                    bf16_t* xp = XB + (size_t)row * DM + col;
                    *(GAS u32x4*)xp = w0; *(GAS u32x4*)(xp + 8) = w1;
                    if (fq == 0) *(GAS float*)(rowss + (size_t)row * 16 + u.pn * 4 + wc) = ss;
                }
            }
    }
};

struct EpiPassA {
    static constexpr bool PERM = false, AFTER_DRAIN = true;
    const f32x2* a64; f32x2* hin; float* out; int layer;
    __device__ __forceinline__ void fused(const f32x4 (&acc)[2][2][4][2], const Unit& u, int wr, int wc, int fr, int fq, PG8_LAS unsigned char* lds, int wid, int lane) const {
        PG8_LAS float* S = (PG8_LAS float*)lds;
#pragma unroll
        for (int ai = 0; ai < 2; ++ai)
#pragma unroll
            for (int m = 0; m < 4; ++m) { const int r = ai * HALF + wr * 64 + m * 16 + fr;
#pragma unroll
                for (int n = 0; n < 2; ++n) *(PG8_LAS f32x4*)(S + r * 128 + wc * 32 + n * 16 + fq * 4) = acc[ai][0][m][n] + acc[ai][1][m][n]; }
        asm volatile("s_waitcnt lgkmcnt(0)" ::: "memory"); __builtin_amdgcn_s_barrier(); asm volatile("" ::: "memory");
        const int tid = wid * 64 + lane;
        if (tid < 256) {
            const int bl = tid >> 6, p = tid & 63, g = u.pm >> 2, b = (u.pm & 3) * 4 + bl;
            const f32x2 a = *(const GAS f32x2*)(a64 + g * 64 + p);
            float hr = 0.f, hi = 0.f;
            f32x2* hp = hin + ((size_t)(b * NCH) * NG + g) * NP + p;
            for (int c = 0; c < NCH; ++c) {
                const f32x2 s = *(const PG8_LAS f32x2*)(S + (bl * 64 + c) * 128 + 2 * p);
                *(GAS f32x2*)(hp + (size_t)c * NG * NP) = (f32x2){hr, hi};
                const float nr = a.x * hr - a.y * hi + s.x, ni = a.x * hi + a.y * hr + s.y;
                hr = nr; hi = ni;
            }
            const size_t o = ((size_t)(layer * NB + b) * NG + g) * NP + p;
            *(GAS float*)(out + O_RP + o) = hr; *(GAS float*)(out + O_IP + o) = hi;
        }
        asm volatile("s_waitcnt lgkmcnt(0)" ::: "memory"); __builtin_amdgcn_s_barrier(); asm volatile("" ::: "memory");
    }
};

template <class Epi, class Sched, class GP, bool ALIGN_EPI = false, bool SP2 = false>
__device__ __forceinline__ void gemm_phase(PG8_LAS unsigned char* lds, const GP& g, const Sched& S, const Epi& E) {
    int tid_ = threadIdx.x; asm volatile("" : "+v"(tid_));
    const int tid = tid_, wid = __builtin_amdgcn_readfirstlane(tid >> 6), lane = tid & 63, wr = wid >> 2, wc = wid & 3, fr = lane & 15, fq = lane >> 4;
    const int nt = g.nt();
    unsigned voffA[2], voffB[2];
#pragma unroll
    for (int i = 0; i < 2; ++i) { int R, C; stage_rc(tid * 16 + i * 8192, R, C); const int Rb = Epi::PERM ? ((R & ~31) + perm32(R & 31)) : R;
        voffA[i] = g.a_voff(R, C); voffB[i] = g.b_voff(Rb, C); }
    const size_t kstepA = g.a_kstep(), kstepB = g.b_kstep(), hstepA = g.a_hstep(), hstepB = g.b_hstep();
    const unsigned ldsw = (unsigned)wid * 1024u;
    const int aoff = lds_byte(wr * 64 + fr, fq * 8), boff = lds_byte(wc * 32 + fr, fq * 8);
#define PG8_SA(b, h) (((b) * 2 + (h)) * HTB)
#define PG8_SB(b, h) ((4 + (b) * 2 + (h)) * HTB)
#define PG8_STAGE(bufoff, gbase, voff) do { _Pragma("unroll") for (int _i = 0; _i < 2; ++_i) \
        __builtin_amdgcn_global_load_lds((const unsigned*)((const char*)(gbase) + (voff)[_i]), (PG8_LAS unsigned*)(lds + (bufoff) + ldsw + _i * 8192), 16, 0, 0); } while (0)
#define PG8_LDA(dst, b, h) do { _Pragma("unroll") for (int m = 0; m < 4; ++m) _Pragma("unroll") for (int k = 0; k < 2; ++k) dst[m][k] = *(const PG8_LAS bf16x8*)(lds + PG8_SA(b, h) + aoff + m * 2048 + k * 1024); } while (0)
#define PG8_LDB(dst, b, h) do { _Pragma("unroll") for (int n = 0; n < 2; ++n) _Pragma("unroll") for (int k = 0; k < 2; ++k) dst[n][k] = *(const PG8_LAS bf16x8*)(lds + PG8_SB(b, h) + boff + n * 2048 + k * 1024); } while (0)
#define PG8_MMA(ai, bj, At, Bt) do { __builtin_amdgcn_s_setprio(1); _Pragma("unroll") for (int m = 0; m < 4; ++m) _Pragma("unroll") for (int n = 0; n < 2; ++n) _Pragma("unroll") for (int k = 0; k < 2; ++k) \
        acc[ai][bj][m][n] = __builtin_amdgcn_mfma_f32_16x16x32_bf16(Bt[n][k], At[m][k], acc[ai][bj][m][n], 0, 0, 0); __builtin_amdgcn_s_setprio(0); } while (0)
#define PG8_WAIT_V(n) asm volatile("s_waitcnt vmcnt(" #n ")" ::: "memory")
#define PG8_WAIT_L(n) asm volatile("s_waitcnt lgkmcnt(" #n ")" ::: "memory")
#define PG8_BAR __builtin_amdgcn_s_barrier()
#define PG8_SCHED __builtin_amdgcn_sched_barrier(0)
    Unit cur, nxt; int ui = 0;
    if (!S.next(0, cur)) return;
    f32x4 acc[2][2][4][2];
#pragma unroll
    for (int a = 0; a < 2; ++a)
#pragma unroll
        for (int b = 0; b < 2; ++b)
#pragma unroll
            for (int m = 0; m < 4; ++m)
#pragma unroll
                for (int n = 0; n < 2; ++n) acc[a][b][m][n] = (f32x4){0.f, 0.f, 0.f, 0.f};
    bf16x8 At[4][2], B0[2][2], B1[2][2];
    const char* cA = g.a_base(cur); const char* cB = g.b_base(cur);
    S.a_ready(cur);
    if constexpr (SP2) {
        PG8_STAGE(PG8_SB(0, 0), cB, voffB); PG8_STAGE(PG8_SB(0, 1), cB + hstepB, voffB); PG8_STAGE(PG8_SA(0, 0), cA, voffA); PG8_STAGE(PG8_SA(0, 1), cA + hstepA, voffA);
        if (wr == 1) PG8_BAR;
        PG8_WAIT_V(2); PG8_BAR;
        PG8_STAGE(PG8_SB(1, 0), cB + kstepB, voffB); PG8_STAGE(PG8_SA(1, 0), cA + kstepA, voffA); PG8_STAGE(PG8_SB(1, 1), cB + hstepB + kstepB, voffB);
        PG8_WAIT_V(6); PG8_BAR;
    } else {
        PG8_STAGE(PG8_SB(0, 0), cB, voffB); PG8_STAGE(PG8_SA(0, 0), cA, voffA); PG8_STAGE(PG8_SB(0, 1), cB + hstepB, voffB); PG8_STAGE(PG8_SA(0, 1), cA + hstepA, voffA);
        if (wr == 1) PG8_BAR;
        PG8_WAIT_V(4); PG8_BAR;
        PG8_STAGE(PG8_SB(1, 0), cB + kstepB, voffB); PG8_STAGE(PG8_SA(1, 0), cA + kstepA, voffA); PG8_STAGE(PG8_SB(1, 1), cB + hstepB + kstepB, voffB);
        PG8_WAIT_V(6); PG8_BAR;
    }
    for (;;) {
        const bool has_next = S.next(ui + 1, nxt);
        const char* nA = has_next ? g.a_base(nxt) : cA; const char* nB = has_next ? g.b_base(nxt) : cB;
        for (int t = 0; t < nt; t += 2) {
            const bool last = (t == nt - 2);
            const char* a1 = cA + (size_t)(t + 1) * kstepA;
            const char* a2 = last ? nA : cA + (size_t)(t + 2) * kstepA; const char* b2 = last ? nB : cB + (size_t)(t + 2) * kstepB;
            const char* a3 = a2 + kstepA; const char* b3 = b2 + kstepB;
            if (last && has_next) S.a_ready(nxt);
            if constexpr (SP2) {
            PG8_LDB(B0, 0, 0); PG8_LDB(B1, 0, 1); PG8_SCHED; PG8_LDA(At, 0, 0); PG8_STAGE(PG8_SA(1, 1), a1 + hstepA, voffA);
            PG8_WAIT_V(8); PG8_WAIT_L(0); PG8_BAR; PG8_MMA(0, 0, At, B0); PG8_MMA(0, 1, At, B1); PG8_BAR; PG8_SCHED;
            PG8_LDA(At, 0, 1); PG8_STAGE(PG8_SB(0, 0), b2, voffB); PG8_STAGE(PG8_SB(0, 1), b2 + hstepB, voffB); PG8_STAGE(PG8_SA(0, 0), a2, voffA);
            PG8_WAIT_V(8); PG8_WAIT_L(0); PG8_BAR; PG8_MMA(1, 0, At, B0); PG8_MMA(1, 1, At, B1); PG8_BAR; PG8_SCHED;
            PG8_LDB(B0, 1, 0); PG8_LDB(B1, 1, 1); PG8_SCHED; PG8_LDA(At, 1, 0); PG8_STAGE(PG8_SA(0, 1), a2 + hstepA, voffA);
            PG8_WAIT_V(8); PG8_WAIT_L(0); PG8_BAR; PG8_MMA(0, 0, At, B0); PG8_MMA(0, 1, At, B1); PG8_BAR; PG8_SCHED;
            PG8_LDA(At, 1, 1); PG8_STAGE(PG8_SB(1, 0), b3, voffB); PG8_STAGE(PG8_SB(1, 1), b3 + hstepB, voffB); PG8_STAGE(PG8_SA(1, 0), a3, voffA);
            PG8_WAIT_V(8); PG8_WAIT_L(0); PG8_BAR; PG8_MMA(1, 0, At, B0); PG8_MMA(1, 1, At, B1); PG8_BAR; PG8_SCHED;
            } else {
            PG8_LDB(B0, 0, 0); PG8_SCHED; PG8_LDA(At, 0, 0); PG8_STAGE(PG8_SA(1, 1), a1 + hstepA, voffA);
            PG8_WAIT_L(8); PG8_BAR; PG8_WAIT_L(0); PG8_MMA(0, 0, At, B0); PG8_BAR; PG8_SCHED;
            PG8_LDB(B1, 0, 1); PG8_STAGE(PG8_SB(0, 0), b2, voffB);
            PG8_BAR; PG8_WAIT_L(0); PG8_MMA(0, 1, At, B1); PG8_BAR;
            PG8_LDA(At, 0, 1); PG8_STAGE(PG8_SA(0, 0), a2, voffA);
            PG8_BAR; PG8_WAIT_L(0); PG8_MMA(1, 0, At, B0); PG8_BAR; PG8_SCHED;
            PG8_STAGE(PG8_SB(0, 1), b2 + hstepB, voffB);
            PG8_WAIT_V(6); PG8_BAR; PG8_MMA(1, 1, At, B1); PG8_BAR;
            PG8_LDB(B0, 1, 0); PG8_SCHED; PG8_LDA(At, 1, 0); PG8_STAGE(PG8_SA(0, 1), a2 + hstepA, voffA);
            PG8_WAIT_L(8); PG8_BAR; PG8_WAIT_L(0); PG8_MMA(0, 0, At, B0); PG8_BAR; PG8_SCHED;
            PG8_LDB(B1, 1, 1); PG8_STAGE(PG8_SB(1, 0), b3, voffB);
            PG8_BAR; PG8_WAIT_L(0); PG8_MMA(0, 1, At, B1); PG8_BAR;
            PG8_LDA(At, 1, 1); PG8_STAGE(PG8_SA(1, 0), a3, voffA);
            PG8_BAR; PG8_WAIT_L(0); PG8_MMA(1, 0, At, B0); PG8_BAR; PG8_SCHED;
            PG8_STAGE(PG8_SB(1, 1), b3 + hstepB, voffB);
            PG8_WAIT_V(6); PG8_BAR; PG8_MMA(1, 1, At, B1); PG8_BAR;
            }
        }
        if constexpr (ALIGN_EPI) { if (wr == 0) PG8_BAR; }
        if constexpr (!Epi::AFTER_DRAIN) { E(acc, cur, wr, wc, fr, fq); S.done(cur); }
        if (!has_next) break;
#pragma unroll
        for (int a = 0; a < 2; ++a)
#pragma unroll
            for (int b = 0; b < 2; ++b)
#pragma unroll
                for (int m = 0; m < 4; ++m)
#pragma unroll
                    for (int n = 0; n < 2; ++n) acc[a][b][m][n] = (f32x4){0.f, 0.f, 0.f, 0.f};
        cur = nxt; cA = nA; cB = nB; ++ui;
        if constexpr (ALIGN_EPI) { if (wr == 1) PG8_BAR; }
    }
    PG8_WAIT_V(0);
    if constexpr (!ALIGN_EPI) { if (wr == 0) PG8_BAR; }
    PG8_BAR;
    if constexpr (Epi::AFTER_DRAIN) { E.fused(acc, cur, wr, wc, fr, fq, lds, wid, lane); S.done(cur); }
#undef PG8_SA
#undef PG8_SB
#undef PG8_STAGE
#undef PG8_LDA
#undef PG8_LDB
#undef PG8_MMA
#undef PG8_WAIT_V
#undef PG8_WAIT_L
#undef PG8_BAR
#undef PG8_SCHED
}
}
struct InPtrs { const float* p[21]; };
typedef const float* fptr_t;
typedef __attribute__((address_space(4))) const fptr_t* kargp_t;
__device__ __forceinline__ int rowmap_inout(int col) {
    const int a = col & 255, wc = a >> 6, fq = (a >> 4) & 3, bj = (a >> 3) & 1, n = (a >> 2) & 1, i = a & 3;
    return (col & ~255) + bj * 128 + wc * 32 + n * 16 + fq * 4 + i;
}
__device__ __forceinline__ int rowmap_glu(int c) {
    const int bj = c >> 9, j = c & 511, pn = j >> 7, jj = j & 127, wc = jj >> 5, fq = (jj >> 3) & 3, n = (jj >> 2) & 1, i = jj & 3;
    return pn * 256 + bj * 128 + wc * 32 + n * 16 + fq * 4 + i;
}
__device__ __forceinline__ void p0_transpose_item(const float* W, int K, int N, bf16_t* WT, int glu, const float* gain, LAS float* scr, int item, int lane) {
    const int nblk = N / 32, kb = item / nblk, nb = item % nblk, k0 = 64 * kb, n0 = 32 * nb;
#pragma unroll 8
    for (int i = 0; i < 32; ++i) { const int kk = 2 * i + (lane >> 5); float w = W[(size_t)(k0 + kk) * N + n0 + (lane & 31)]; if (gain) w *= gain[k0 + kk]; scr[kk * 33 + (lane & 31)] = w; }
    asm volatile("s_waitcnt lgkmcnt(0)" ::: "memory");
    const int c = lane & 7;
#pragma unroll
    for (int j = 0; j < 4; ++j) { const int n = (lane >> 3) + 8 * j; const LAS float* s = scr + (8 * c) * 33 + n;
        u32x4 o; o.x = pk2(s[0 * 33], s[1 * 33]); o.y = pk2(s[2 * 33], s[3 * 33]); o.z = pk2(s[4 * 33], s[5 * 33]); o.w = pk2(s[6 * 33], s[7 * 33]);
        const int dr = glu ? rowmap_glu(n0 + n) : rowmap_inout(n0 + n);
        *(u32x4*)(WT + (size_t)dr * K + k0 + 8 * c) = o; }
    asm volatile("s_waitcnt lgkmcnt(0)" ::: "memory");
}
__device__ __forceinline__ float wave_sum(float v) {
#pragma unroll
    for (int o = 1; o < 64; o <<= 1) v += __shfl_xor(v, o);
    return v;
}
struct Disc { double abr, abi, fr, fi, dt, ar, ai; };
__device__ __forceinline__ Disc s5_disc(kargp_t in, int l, int g, int p) {
    Disc d; d.ar = (double)in[8][(l * NG + g) * NP + p]; d.ai = (double)in[9][(l * NG + g) * NP + p]; d.dt = exp((double)in[15][l * NG + g]);
    const double mag = exp(d.dt * d.ar); double s, c; sincos(d.dt * d.ai, &s, &c);
    d.abr = mag * c; d.abi = mag * s;
    const double den = d.ar * d.ar + d.ai * d.ai, nr = d.abr - 1.0;
    d.fr = (nr * d.ar + d.abi * d.ai) / den; d.fi = (d.abi * d.ar - nr * d.ai) / den;
    return d;
}
__device__ __forceinline__ int crow(int r, int hi) { return (r & 3) + 8 * (r >> 2) + 4 * hi; }

__device__ __forceinline__ void p0_prologue(unsigned char* ws, LAS unsigned char* lds, int vcu, int G, int tid) {
    const int lane = tid & 63, wave = tid >> 6;
    kargp_t in = (kargp_t)__builtin_amdgcn_kernarg_segment_ptr(); asm volatile("" : "+s"(in));
    LAS float* scr = (LAS float*)(lds + wave * 16384);
    const int gw = vcu * 8 + wave, NGW = G * 8;
    constexpr int I_IN = (DM / 64) * (DIN / 32), I_GLU = (DS / 64) * (2 * DS / 32), I_OUT = (DM / 64) * (DM / 32), I_L = I_IN + I_GLU + I_OUT;
    for (int it = gw; it < NL * I_L; it += NGW) {
        const int l = it / I_L; int r = it % I_L;
        if (r < I_IN) { p0_transpose_item(in[7] + (size_t)l * DM * DIN, DM, DIN, (bf16_t*)(ws + WS_WIN + l * WIN_L), 0, in[6] + l * DM, scr, r, lane); continue; } r -= I_IN;
        if (r < I_GLU) { p0_transpose_item(in[16] + (size_t)l * DS * 2 * DS, DS, 2 * DS, (bf16_t*)(ws + WS_WGLU + l * WGLU_L), 1, nullptr, scr, r, lane); continue; } r -= I_GLU;
        p0_transpose_item(in[20] + (size_t)l * DM * DM, DM, DM, (bf16_t*)(ws + WS_WOUT + l * WOUT_L), 0, nullptr, scr, r, lane);
    }
    asm volatile("" : "+s"(in), "+s"(ws));
    {
        bf16_t* XB = (bf16_t*)(ws + WS_XB); float* rowss = (float*)(ws + WS_ROWSS);
        for (int m = gw; m < MT; m += NGW) {
            const float* xr = (m < MP) ? in[0] + (size_t)m * DM : in[1] + (size_t)(m - MP) * DM;
            f32x4 v[4]; float s = 0.f;
#pragma unroll
            for (int j = 0; j < 4; ++j) { v[j] = *(const f32x4*)(xr + 4 * lane + 256 * j); s += (v[j].x * v[j].x + v[j].y * v[j].y) + (v[j].z * v[j].z + v[j].w * v[j].w); }
            s = wave_sum(s);
#pragma unroll
            for (int j = 0; j < 4; ++j) { u32x2 o; o.x = pk2(v[j].x, v[j].y); o.y = pk2(v[j].z, v[j].w); *(u32x2*)(XB + (size_t)m * DM + 4 * lane + 256 * j) = o; }
            if (lane < 16) rowss[(size_t)m * 16 + lane] = (lane == 0) ? s : 0.f;
        }
    }
    asm volatile("" : "+s"(in), "+s"(ws));
    const int gt = vcu * 512 + tid, NGT = G * 512;
    for (int it = gt; it < NL * NG * NP; it += NGT) {
        const int l = it / (NG * NP), g = (it / NP) % NG, p = it % NP;
        const Disc d = s5_disc(in, l, g, p);
        unsigned char* tb = ws + WS_TAB + l * TAB_L;
        ((f32x2*)(tb + T_AB))[g * NP + p] = (f32x2){(float)d.abr, (float)d.abi};
        const double m64 = exp(64.0 * d.dt * d.ar); double s, c; sincos(64.0 * d.dt * d.ai, &s, &c);
        ((f32x2*)(tb + T_A64))[g * NP + p] = (f32x2){(float)(m64 * c), (float)(m64 * s)};
    }
    asm volatile("" : "+s"(in), "+s"(ws));
    for (int it = gt; it < NL * NG * 8 * 64; it += NGT) {
        const int l = it / (NG * 512), g = (it / 512) % NG, cb = (it / 64) % 8, ln = it % 64;
        const int p = 16 * (cb >> 1) + (ln & 15), ri = cb & 1;
        const Disc d = s5_disc(in, l, g, p);
        unsigned short o[8];
#pragma unroll
        for (int j = 0; j < 8; ++j) { const int k = 8 * (ln >> 4) + j, h = k & 15;
            const double br = (double)in[10][((size_t)(l * NG + g) * NP + p) * NCHN + h], bi = (double)in[11][((size_t)(l * NG + g) * NP + p) * NCHN + h];
            const float val = (float)(ri ? (d.fr * bi + d.fi * br) : (d.fr * br - d.fi * bi));
            const unsigned hi = f2bf(val); const unsigned lo = f2bf(val - bf2f(hi));
            o[j] = (unsigned short)(k < 16 ? hi : lo); }
        u32x4 w; w.x = o[0] | (o[1] << 16); w.y = o[2] | (o[3] << 16); w.z = o[4] | (o[5] << 16); w.w = o[6] | (o[7] << 16);
        ((u32x4*)(ws + WS_TAB + l * TAB_L + T_BU))[(g * 8 + cb) * 64 + ln] = w;
    }
    asm volatile("" : "+s"(in), "+s"(ws));
    for (int it = gt; it < NL * NG * 5 * 64; it += NGT) {
        const int l = it / (NG * 320), g = (it / 320) % NG, kb = (it / 64) % 5, ln = it % 64, h = ln & 15;
        unsigned short o[8];
        if (kb == 4) { const float dv = in[14][(l * NG + g) * NCHN + h]; const unsigned hi = f2bf(dv), lo = f2bf(dv - bf2f(hi));
#pragma unroll
            for (int j = 0; j < 8; ++j) { const int k = 8 * (ln >> 4) + j; o[j] = (unsigned short)(((k & 15) == h) ? (k < 16 ? hi : lo) : 0u); }
            u32x4 w; w.x = o[0] | (o[1] << 16); w.y = o[2] | (o[3] << 16); w.z = o[4] | (o[5] << 16); w.w = o[6] | (o[7] << 16);
            ((u32x4*)(ws + WS_TAB + l * TAB_L + T_D))[g * 64 + ln] = w;
        } else {
#pragma unroll
            for (int j = 0; j < 8; ++j) { const int kk = 8 * (ln >> 4) + j, p = 16 * kb + (kk >> 1), ri = kk & 1;
                const size_t ci = ((size_t)(l * NG + g) * NCHN + h) * NP + p;
                const float val = ri ? -in[13][ci] : in[12][ci]; o[j] = (unsigned short)f2bf(val); }
            u32x4 w; w.x = o[0] | (o[1] << 16); w.y = o[2] | (o[3] << 16); w.z = o[4] | (o[5] << 16); w.w = o[6] | (o[7] << 16);
            ((u32x4*)(ws + WS_TAB + l * TAB_L + T_C))[(g * 4 + kb) * 64 + ln] = w;
        }
    }
    asm volatile("" : "+s"(in), "+s"(ws));
    for (int it = gt; it < NL * NG * NP * 64; it += NGT) {
        const int l = it / (NG * NP * 64), g = (it / (NP * 64)) % NG, p = (it / 64) % NP, s = it % 64;
        const Disc d = s5_disc(in, l, g, p);
        const double n = (double)(63 - s), mg = exp(n * d.dt * d.ar); double sn, cs; sincos(n * d.dt * d.ai, &sn, &cs);
        const double wr = mg * cs, wi = mg * sn;
        const double zr = wr * d.fr - wi * d.fi, zi = wr * d.fi + wi * d.fr;
        unsigned short orh[16], oih[16], orl[16], oil[16];
#pragma unroll
        for (int h = 0; h < 16; ++h) {
            const double br = (double)in[10][((size_t)(l * NG + g) * NP + p) * NCHN + h], bi = (double)in[11][((size_t)(l * NG + g) * NP + p) * NCHN + h];
            const float vr = (float)(zr * br - zi * bi), vi = (float)(zr * bi + zi * br);
            const unsigned hr = f2bf(vr), hi = f2bf(vi);
            orh[h] = (unsigned short)hr; oih[h] = (unsigned short)hi; orl[h] = (unsigned short)f2bf(vr - bf2f(hr)); oil[h] = (unsigned short)f2bf(vi - bf2f(hi));
        }
        bf16_t* pm = (bf16_t*)(ws + WS_PM + l * PM_L) + (size_t)g * 256 * 1024 + 16 * s;
#pragma unroll
        for (int q = 0; q < 2; ++q) {
            u32x4 a, b, c, e;
            a.x = orh[8*q] | (orh[8*q+1] << 16); a.y = orh[8*q+2] | (orh[8*q+3] << 16); a.z = orh[8*q+4] | (orh[8*q+5] << 16); a.w = orh[8*q+6] | (orh[8*q+7] << 16);
            b.x = oih[8*q] | (oih[8*q+1] << 16); b.y = oih[8*q+2] | (oih[8*q+3] << 16); b.z = oih[8*q+4] | (oih[8*q+5] << 16); b.w = oih[8*q+6] | (oih[8*q+7] << 16);
            c.x = orl[8*q] | (orl[8*q+1] << 16); c.y = orl[8*q+2] | (orl[8*q+3] << 16); c.z = orl[8*q+4] | (orl[8*q+5] << 16); c.w = orl[8*q+6] | (orl[8*q+7] << 16);
            e.x = oil[8*q] | (oil[8*q+1] << 16); e.y = oil[8*q+2] | (oil[8*q+3] << 16); e.z = oil[8*q+4] | (oil[8*q+5] << 16); e.w = oil[8*q+6] | (oil[8*q+7] << 16);
            *(u32x4*)(pm + (size_t)(2 * p) * 1024 + 8 * q) = a; *(u32x4*)(pm + (size_t)(2 * p + 1) * 1024 + 8 * q) = b;
            *(u32x4*)(pm + (size_t)(128 + 2 * p) * 1024 + 8 * q) = c; *(u32x4*)(pm + (size_t)(128 + 2 * p + 1) * 1024 + 8 * q) = e;
        }
    }
    asm volatile("" : "+s"(in), "+s"(ws));
    for (int it = gt; it < NL * NH * 4 * 2 * 2 * 64; it += NGT) {
        const int l = it / (NH * 1024), h = (it / 1024) % NH, v = (it / 256) % 4, qh = (it / 128) % 2, pp = (it / 64) % 2, ln = it % 64;
        const float* tab = in[19] + (size_t)(l * NH + h) * NREL;
        const int j = (v == 3) ? 8 : 6 + v, q = 32 * qh + (ln & 31), hi = ln >> 5;
        float o[16];
#pragma unroll
        for (int r = 0; r < 16; ++r) { const int kk = crow(r, hi) + 32 * pp; int dist = q + 512 - 64 * j - kk; dist = dist < -128 ? -128 : (dist > 128 ? 128 : dist);
            o[r] = (v == 3 && kk >= 16) ? -1e30f : (tab[dist + 128] - tab[256]) * LOG2E; }
        float* bp = (float*)(ws + WS_TAB + l * TAB_L + T_BIAS) + ((size_t)(((h * 4 + v) * 2 + qh) * 2 + pp) * 64 + ln) * 16;
#pragma unroll
        for (int r4 = 0; r4 < 4; ++r4) *(f32x4*)(bp + 4 * r4) = (f32x4){o[4 * r4], o[4 * r4 + 1], o[4 * r4 + 2], o[4 * r4 + 3]};
    }
}
__global__ void __launch_bounds__(64) naive_s5(InPtrs I, unsigned char* ws, float* out, int layer) {
    __shared__ float sh_hr[64], sh_hi[64], sh_c[2][16][64], sh_part[64];
    const int p = threadIdx.x, blk = blockIdx.x;
    const bool samp = blk >= NB * NG;
    const int seq = samp ? (blk - NB * NG) / NG : blk / NG, g = blk % NG;
    const int L = samp ? SSEQ : SEQ;
    const size_t row0 = samp ? (size_t)MP + (size_t)seq * SSEQ : (size_t)seq * SEQ;
    const float* const* in = I.p;
    const int gi = (layer * NG + g) * NP + p;
    const float ar = in[8][gi], ai = in[9][gi], dt = expf(in[15][layer * NG + g]);
    const float mag = expf(dt * ar), abr = mag * cosf(dt * ai), abi = mag * sinf(dt * ai);
    const float den = ar * ar + ai * ai, nr = abr - 1.0f, fr = (nr * ar + abi * ai) / den, fi = (abi * ar - nr * ai) / den;
    float bbr[16], bbi[16];
    _Pragma("unroll") for (int h = 0; h < 16; ++h) { const float br = in[10][(size_t)gi * 16 + h], bi = in[11][(size_t)gi * 16 + h]; bbr[h] = fr * br - fi * bi; bbi[h] = fr * bi + fi * br; }
    _Pragma("unroll") for (int h = 0; h < 16; ++h) { sh_c[0][h][p] = in[12][((size_t)(layer * NG + g) * 16 + h) * NP + p]; sh_c[1][h][p] = in[13][((size_t)(layer * NG + g) * 16 + h) * NP + p]; }
    float hr = 0.f, hi = 0.f;
    if (samp) { hr = in[4][((size_t)(layer * SBAT + seq) * NG + g) * NP + p]; hi = in[5][((size_t)(layer * SBAT + seq) * NG + g) * NP + p]; }
    const bf16_t* U = (const bf16_t*)(ws + WS_U); bf16_t* YG = (bf16_t*)(ws + WS_YG);
    const int hh = p & 15, qq = p >> 4;
    const float dv = in[14][(layer * NG + g) * 16 + hh];
    __syncthreads();
    for (int t = 0; t < L; ++t) {
        const bf16_t* ur = U + (row0 + t) * 512 + g * 16;
        float bur = 0.f, bui = 0.f, uh = 0.f;
        _Pragma("unroll") for (int h = 0; h < 16; ++h) { const float u = bf2f(ur[h]); bur += bbr[h] * u; bui += bbi[h] * u; if (h == hh) uh = u; }
        const float nhr = abr * hr - abi * hi + bur, nhi = abr * hi + abi * hr + bui; hr = nhr; hi = nhi;
        sh_hr[p] = hr; sh_hi[p] = hi;
        __syncthreads();
        float acc = 0.f;
        for (int k = 0; k < 16; ++k) { const int pp = qq * 16 + k; acc += sh_hr[pp] * sh_c[0][hh][pp] - sh_hi[pp] * sh_c[1][hh][pp]; }
        sh_part[p] = acc;
        __syncthreads();
        if (p < 16) { const float y = sh_part[p] + sh_part[p + 16] + sh_part[p + 32] + sh_part[p + 48] + dv * uh; YG[(row0 + t) * 512 + g * 16 + p] = (bf16_t)f2bf(gelu_tanh(y)); }
        __syncthreads();
    }
    if (samp) { const size_t o = ((size_t)(layer * SBAT + seq) * NG + g) * NP + p; out[O_RS + o] = hr; out[O_IS + o] = hi; }
    else { const size_t o = ((size_t)(layer * NB + seq) * NG + g) * NP + p; out[O_RP + o] = hr; out[O_IP + o] = hi; }
}
__global__ void __launch_bounds__(256) naive_attn(InPtrs I, unsigned char* ws, int layer) {
    const int gid = blockIdx.x * 256 + threadIdx.x;
    const bf16_t* Q = (const bf16_t*)(ws + WS_Q); const bf16_t* K = (const bf16_t*)(ws + WS_K); const bf16_t* V = (const bf16_t*)(ws + WS_V); const bf16_t* SGA = (const bf16_t*)(ws + WS_SGA);
    bf16_t* MIX = (bf16_t*)(ws + WS_MIX);
    const bool samp = gid >= MP * NH;
    int h, qi; size_t row;
    const int lid = samp ? gid - MP * NH : gid;
    size_t base_row; int nkeys; int j0 = 0;
    if (!samp) { const int b = lid / (NH * SEQ); h = (lid / SEQ) % NH; const int t = lid % SEQ; row = (size_t)b * SEQ + t; qi = t & 63; const int n = t >> 6; j0 = (n >= 8) ? 0 : 8 - n; base_row = (size_t)((long)b * SEQ + (long)(n - 8) * 64); nkeys = 576; }
    else { if (lid >= MS * NH) return; const int s = lid / (NH * SSEQ); h = (lid / SSEQ) % NH; qi = lid % SSEQ; row = (size_t)MP + s * SSEQ + qi; base_row = (size_t)s; nkeys = 528; }
    const float* tab = I.p[19] + (size_t)(layer * NH + h) * NREL;
    float q[64], o[64];
    _Pragma("unroll") for (int d = 0; d < 64; ++d) { q[d] = bf2f(Q[row * 512 + h * 64 + d]); o[d] = 0.f; }
    float m = -3.0e38f, l = 0.f;
    for (int kj = j0 * 64; kj < nkeys; ++kj) {
        float kv[64]; float s = 0.f;
        if (!samp) { const bf16_t* kr = K + (base_row + kj) * 512 + h * 64; _Pragma("unroll") for (int d = 0; d < 64; ++d) s += q[d] * bf2f(kr[d]); }
        else if (kj < PAST) { const float* kr = I.p[2] + (((size_t)(layer * SBAT + base_row) * PAST + kj) * NH + h) * HD; _Pragma("unroll") for (int d = 0; d < 64; ++d) s += q[d] * kr[d]; }
        else { const bf16_t* kr = K + ((size_t)MP + base_row * SSEQ + (kj - PAST)) * 512 + h * 64; _Pragma("unroll") for (int d = 0; d < 64; ++d) s += q[d] * bf2f(kr[d]); }
        int dist = qi + 512 - kj; dist = dist < -128 ? -128 : (dist > 128 ? 128 : dist);
        s += tab[dist + 128] * LOG2E;
        const float mn = fmaxf(m, s), al = exp2f(m - mn), pe = exp2f(s - mn);
        l = l * al + pe; m = mn;
        if (!samp) { const bf16_t* vr = V + (base_row + kj) * 512 + h * 64; _Pragma("unroll") for (int d = 0; d < 64; ++d) kv[d] = bf2f(vr[d]); }
        else if (kj < PAST) { const float* vr = I.p[3] + (((size_t)(layer * SBAT + base_row) * PAST + kj) * NH + h) * HD; _Pragma("unroll") for (int d = 0; d < 64; ++d) kv[d] = vr[d]; }
        else { const bf16_t* vr = V + ((size_t)MP + base_row * SSEQ + (kj - PAST)) * 512 + h * 64; _Pragma("unroll") for (int d = 0; d < 64; ++d) kv[d] = bf2f(vr[d]); }
        _Pragma("unroll") for (int d = 0; d < 64; ++d) o[d] = o[d] * al + pe * kv[d];
    }
    const float rl = 1.0f / l;
    _Pragma("unroll") for (int d = 0; d < 64; ++d) MIX[row * 1024 + 512 + h * 64 + d] = (bf16_t)f2bf(o[d] * rl * bf2f(SGA[row * 512 + h * 64 + d]));
}
#ifndef PHMASK
#define PHMASK 0xFF
#endif
constexpr int LDS_BYTES = 147456;
constexpr int NPHASE = 1 + 5 * NL;
struct Args { InPtrs in; float* out; unsigned char* ws; int ph_lo, ph_hi; };

template <bool COOP>
__global__ void __launch_bounds__(512, 2) fwd(Args a) {
    extern __shared__ __attribute__((aligned(16))) unsigned char lds_raw[];
    LAS unsigned char* lds = (LAS unsigned char*)lds_raw;
    const int tid = threadIdx.x, G = gridDim.x, bx = blockIdx.x;
    const int vcu = (G % 8 == 0) ? (bx % 8) * (G / 8) + bx / 8 : bx;
    if (a.ph_lo == 0) {
        unsigned char* ws = a.ws; asm volatile("" : "+s"(ws));
        p0_prologue(ws, lds, vcu, G, tid);
        if (a.ph_hi > 1) { if constexpr (COOP) { cg::this_grid().sync(); } }
    }
    for (int ph = (a.ph_lo < 1 ? 1 : a.ph_lo); ph < a.ph_hi; ++ph) {
        unsigned char* ws = a.ws; float* out = a.out; asm volatile("" : "+s"(ws), "+s"(out));
        {
            const int l = (ph - 1) / 5, k = (ph - 1) % 5;
            if (k == 0 && (PHMASK & 2)) {
                pg8::GemmStd g{(const char*)(ws + WS_XB), (const char*)(ws + WS_WIN + l * WIN_L), DM};
                pg8::StaticOrder S; S.init(MT, DIN, G, bx);
                pg8::EpiInProj E{(const float*)(ws + WS_ROWSS), ws, a.in.p[17] + l * HD, a.in.p[18] + l * HD, out, l};
                pg8::gemm_phase<pg8::EpiInProj, pg8::StaticOrder, pg8::GemmStd, true, true>(lds, g, S, E);
            } else if (k == 3 && (PHMASK & 16)) {
                pg8::GemmStd g{(const char*)(ws + WS_YG), (const char*)(ws + WS_WGLU + l * WGLU_L), DS};
                pg8::StaticOrder S; S.init(MT, 2 * DS, G, bx);
                pg8::EpiGlu E{(const bf16_t*)(ws + WS_SG), (bf16_t*)(ws + WS_MIX)};
                pg8::gemm_phase<pg8::EpiGlu, pg8::StaticOrder, pg8::GemmStd, true, true>(lds, g, S, E);
            } else if (k == 4 && (PHMASK & 32)) {
                pg8::GemmStd g{(const char*)(ws + WS_MIX), (const char*)(ws + WS_WOUT + l * WOUT_L), DM};
                pg8::StaticOrder S; S.init(MT, DM, G, bx);
                pg8::EpiOut E{l == 0 ? a.in.p[0] : out + O_YP, l == 0 ? a.in.p[1] : out + O_YS, out + O_YP, out + O_YS, (bf16_t*)(ws + WS_XB), (float*)(ws + WS_ROWSS), l == 0 ? 1 : 0};
                pg8::gemm_phase<pg8::EpiOut, pg8::StaticOrder, pg8::GemmStd, true, true>(lds, g, S, E);
            }
        }
        if (ph + 1 < a.ph_hi) { if constexpr (COOP) { cg::this_grid().sync(); } }
    }
}

extern "C" void kernel_launch(void* const* d_in, const int* in_sizes, int n_in, void* d_out, int out_size, void* d_ws, size_t ws_size, hipStream_t stream) {
    static int grid = 0;
    if (grid == 0) {
        if (n_in != 21 || (size_t)out_size != O_END || ws_size < WS_END) { fprintf(stderr, "kernel_launch: unexpected shapes (n_in %d out %d ws %zu)\n", n_in, out_size, ws_size); grid = -1; return; }
        int dev = 0, cus = 0;
        hipGetDevice(&dev); hipDeviceGetAttribute(&cus, hipDeviceAttributeMultiprocessorCount, dev);
        hipFuncSetAttribute((const void*)fwd<false>, hipFuncAttributeMaxDynamicSharedMemorySize, LDS_BYTES);
        grid = cus;
    }
    if (grid < 0) return;
    hipMemsetAsync((char*)d_ws + WS_CTL, 0, CTL_BYTES, stream);
    Args a{};
    for (int i = 0; i < 21; ++i) a.in.p[i] = (const float*)d_in[i];
    a.out = (float*)d_out; a.ws = (unsigned char*)d_ws;
    auto run = [&](int lo, int hi) { a.ph_lo = lo; a.ph_hi = hi; hipLaunchKernelGGL(fwd<false>, dim3(grid), dim3(512), LDS_BYTES, stream, a); };
    run(0, 1);
    for (int l = 0; l < NL; ++l) {
        run(1 + 5 * l, 2 + 5 * l);
        hipLaunchKernelGGL(naive_s5, dim3(NB * NG + SBAT * NG), dim3(64), 0, stream, a.in, a.ws, a.out, l);
        hipLaunchKernelGGL(naive_attn, dim3((MP * NH + MS * NH) / 256), dim3(256), 0, stream, a.in, a.ws, l);
        run(4 + 5 * l, 5 + 5 * l);
        run(5 + 5 * l, 6 + 5 * l);
    }
}
```

```cpp
#include <hip/hip_runtime.h>
#include <hip/hip_cooperative_groups.h>
#include <cstdio>
#include <cstdint>
#include <cmath>
namespace cg = cooperative_groups;

#define LAS __attribute__((address_space(3)))
#define GAS __attribute__((address_space(1)))
typedef unsigned short bf16_t;
typedef short bf16x8 __attribute__((ext_vector_type(8)));
typedef short s16x4 __attribute__((ext_vector_type(4)));
typedef float f32x2 __attribute__((ext_vector_type(2)));
typedef float f32x4 __attribute__((ext_vector_type(4)));
typedef float f32x16 __attribute__((ext_vector_type(16)));
typedef unsigned u32x2 __attribute__((ext_vector_type(2)));
typedef unsigned u32x4 __attribute__((ext_vector_type(4)));

constexpr int DM = 1024, NB = 16, SEQ = 4096, NL = 2, SBAT = 32, SSEQ = 16, PAST = 512;
constexpr int MP = NB * SEQ, MS = SBAT * SSEQ, MT = MP + MS;
constexpr int DS = 512, NG = 32, NP = 64, NCHN = 16, NH = 8, HD = 64, DIN = 3072, NREL = 257;
constexpr int NCH = SEQ / 64;
constexpr float EPS = 1e-6f;
constexpr float LOG2E = 1.4426950408889634f;
constexpr float QSCALE = 0.125f * LOG2E;

constexpr size_t O_YP = 0, O_YS = 67108864, O_KP = 67633152, O_VP = 76021760, O_RP = 84410368, O_IP = 84475904,
                 O_KS = 84541440, O_VS = 85065728, O_RS = 85590016, O_IS = 85721088, O_END = 85852160;

constexpr size_t MiB = 1u << 20;
constexpr size_t WS_CTL = 0, CTL_BYTES = 1 * MiB;
constexpr size_t WS_WIN = 1 * MiB, WIN_L = 6 * MiB;
constexpr size_t WS_WGLU = 13 * MiB, WGLU_L = 1 * MiB;
constexpr size_t WS_WOUT = 15 * MiB, WOUT_L = 2 * MiB;
constexpr size_t WS_TAB = 19 * MiB, TAB_L = 2 * MiB;
constexpr size_t WS_PM = 24 * MiB, PM_L = 16 * MiB;
constexpr size_t WS_ROWSS = 56 * MiB;
constexpr size_t WS_HIN = 61 * MiB;
constexpr size_t WS_XB = 77 * MiB;
constexpr size_t ACT_STRIDE = 65 * MiB;
constexpr size_t WS_U = 206 * MiB, WS_SG = WS_U + ACT_STRIDE, WS_Q = WS_SG + ACT_STRIDE, WS_K = WS_Q + ACT_STRIDE, WS_V = WS_K + ACT_STRIDE,
                 WS_SGA = WS_V + ACT_STRIDE, WS_YG = WS_SGA + ACT_STRIDE, WS_MIX = WS_YG + ACT_STRIDE, WS_END = WS_MIX + 129 * MiB;
static_assert(WS_END <= 1024 * MiB, "workspace");
constexpr size_t T_AB = 0, T_A64 = 16384, T_BU = 32768, T_D = T_BU + 262144, T_C = T_D + 32768, T_BIAS = T_C + 131072, T_END = T_BIAS + 524288;
static_assert(T_END <= TAB_L, "tables");
constexpr int CW_QUEUE = 1024;
constexpr int CW_BAR = 8192;

__device__ __forceinline__ unsigned f2bf(float f) { unsigned u = __builtin_bit_cast(unsigned, f); return (u + 0x7fffu + ((u >> 16) & 1u)) >> 16; }
__device__ __forceinline__ float bf2f(unsigned h) { return __builtin_bit_cast(float, h << 16); }
__device__ __forceinline__ unsigned pk2(float lo, float hi) { return f2bf(lo) | (f2bf(hi) << 16); }
__device__ __forceinline__ float silu_f(float x) { return x / (1.0f + __expf(-x)); }
__device__ __forceinline__ float sigmoid_f(float x) { return 1.0f / (1.0f + __expf(-x)); }
__device__ __forceinline__ float gelu_tanh(float x) { const float u = 0.7978845608028654f * (x + 0.044715f * x * x * x); const float e = __expf(2.0f * u); const float t = 1.0f - 2.0f / (e + 1.0f); return 0.5f * x * (1.0f + t); }
namespace pg8 {
#define PG8_LAS __attribute__((address_space(3)))
constexpr int BM = 256, BK = 64, HALF = 128, HTB = HALF * BK * 2  , STAGE_BYTES = 8 * HTB, NXCD = 8, WGM = 8;

__host__ __device__ __forceinline__ int lds_byte(int r, int c) { const int st = (r >> 4) * 2 + (c >> 5), rr = r & 15, cc = c & 31, ob = rr * 64 + cc * 2; return st * 1024 + (ob ^ (((ob >> 9) & 1) << 5)); }
__host__ __device__ __forceinline__ void stage_rc(int b, int& R, int& C) { const int st = b / 1024, sb = b % 1024, swz = sb ^ (((sb >> 9) & 1) << 5); R = (st >> 1) * 16 + swz / 64; C = (st & 1) * 32 + (swz % 64) / 2; }
__host__ __device__ __forceinline__ int perm32(int rho) { const int n = rho >> 4, i = rho & 15; return 8 * (i >> 2) + 4 * n + (i & 3); }

struct Unit { int pm, pn; };

struct GemmStd {
    const char* A; const char* Bt; int K;
    __device__ __forceinline__ const char* a_base(const Unit& u) const { return A + (size_t)u.pm * BM * K * 2; }
    __device__ __forceinline__ const char* b_base(const Unit& u) const { return Bt + (size_t)u.pn * BM * K * 2; }
    __device__ __forceinline__ unsigned a_voff(int R, int C) const { return (unsigned)(R * K + C) * 2u; }
    __device__ __forceinline__ unsigned b_voff(int R, int C) const { return (unsigned)(R * K + C) * 2u; }
    __device__ __forceinline__ size_t a_kstep() const { return BK * 2; }
    __device__ __forceinline__ size_t b_kstep() const { return BK * 2; }
    __device__ __forceinline__ size_t a_hstep() const { return (size_t)HALF * K * 2; }
    __device__ __forceinline__ size_t b_hstep() const { return (size_t)HALF * K * 2; }
    __device__ __forceinline__ int nt() const { return K / BK; }
};
struct GemmPassA {
    const char* U; const char* PM;
    __device__ __forceinline__ const char* a_base(const Unit& u) const { return U + (size_t)(u.pm >> 2) * 32 + (size_t)(u.pm & 3) * 256 * 65536; }
    __device__ __forceinline__ const char* b_base(const Unit& u) const { return PM + (size_t)(u.pm >> 2) * (256 * 1024 * 2); }
    __device__ __forceinline__ unsigned a_voff(int R, int C) const { return (unsigned)R * 65536u + (unsigned)(C >> 4) * 1024u + (unsigned)(C & 15) * 2u; }
    __device__ __forceinline__ unsigned b_voff(int R, int C) const { return (unsigned)(R * 1024 + C) * 2u; }
    __device__ __forceinline__ size_t a_kstep() const { return 4096; }
    __device__ __forceinline__ size_t b_kstep() const { return BK * 2; }
    __device__ __forceinline__ size_t a_hstep() const { return (size_t)HALF * 65536; }
    __device__ __forceinline__ size_t b_hstep() const { return (size_t)HALF * 1024 * 2; }
    __device__ __forceinline__ int nt() const { return 16; }
};

struct StaticOrder {
    int nM, nN, nwg, G, c;
    __host__ __device__ void init(int M, int N, int G_, int c_) { nM = M / BM; nN = N / BM; nwg = nM * nN; G = G_; c = c_; }
    __host__ __device__ bool next(int i, Unit& u) const {
        const long L = (long)i * G + c; if (L >= nwg) return false;
        int wgid = (int)L; { const int q = nwg / NXCD, r = nwg % NXCD, xcd = wgid % NXCD, off = wgid / NXCD; wgid = (xcd < r ? xcd * (q + 1) : r * (q + 1) + (xcd - r) * q) + off; }
        const int nig = WGM * nN, gid = wgid / nig, fm = gid * WGM, gsz = (nM - fm) < WGM ? (nM - fm) : WGM;
        u.pm = fm + ((wgid % nig) % gsz); u.pn = (wgid % nig) / gsz; return true;
    }
    __device__ __forceinline__ void a_ready(const Unit&) const {}
    __device__ __forceinline__ void done(const Unit&) const {}
};
struct OneUnitOrder {
    int n, c;
    __device__ __forceinline__ bool next(int i, Unit& u) const { if (i != 0 || c >= n) return false; u.pm = c; u.pn = 0; return true; }
    __device__ __forceinline__ void a_ready(const Unit&) const {}
    __device__ __forceinline__ void done(const Unit&) const {}
};


struct EpiInProj {
    static constexpr bool PERM = false, AFTER_DRAIN = false;
    const float* rowss; unsigned char* ws; const float* qg; const float* kg; float* out; int layer;
    __device__ __forceinline__ void operator()(const f32x4 (&acc)[2][2][4][2], const Unit& u, int wr, int wc, int fr, int fq) const {
        const int kind = u.pn >> 1;
        bf16_t* dst = (bf16_t*)(ws + WS_U + (size_t)kind * ACT_STRIDE);
        const int colb = (u.pn & 1) * 256 + wc * 64 + fq * 16;
        float gv[16];
#pragma unroll
        for (int e = 0; e < 16; ++e) gv[e] = 1.f;
        if (kind == 2 || kind == 3) { const float* gp = (kind == 2 ? qg : kg) + fq * 16;
#pragma unroll
            for (int e4 = 0; e4 < 4; ++e4) { const f32x4 t = *(const GAS f32x4*)(gp + 4 * e4); gv[4 * e4] = t.x; gv[4 * e4 + 1] = t.y; gv[4 * e4 + 2] = t.z; gv[4 * e4 + 3] = t.w; }
            if (kind == 2) {
#pragma unroll
                for (int e = 0; e < 16; ++e) gv[e] *= QSCALE; } }
        const bool want_out = (kind == 3 || kind == 4) && (u.pm >= 256 || (u.pm & 15) >= 14);
        float* ob = out + (kind == 3 ? (u.pm >= 256 ? O_KS : O_KP) : (u.pm >= 256 ? O_VS : O_VP));
#pragma unroll
        for (int ai = 0; ai < 2; ++ai)
#pragma unroll
            for (int m = 0; m < 4; ++m) {
                const int row = u.pm * BM + ai * HALF + wr * 64 + m * 16 + fr;
                const f32x4 pr = *(const GAS f32x4*)(rowss + (size_t)row * 16 + fq * 4);
                float ss = (pr.x + pr.y) + (pr.z + pr.w); ss += __shfl_xor(ss, 16); ss += __shfl_xor(ss, 32);
                const float rstd = rsqrtf(ss * (1.0f / 1024.0f) + EPS);
                float v[16];
#pragma unroll
                for (int bj = 0; bj < 2; ++bj)
#pragma unroll
                    for (int n = 0; n < 2; ++n)
#pragma unroll
                        for (int i = 0; i < 4; ++i) v[8 * bj + 4 * n + i] = acc[ai][bj][m][n][i] * rstd;
                if (kind == 1 || kind == 5) {
#pragma unroll
                    for (int e = 0; e < 16; ++e) v[e] = silu_f(v[e]);
                } else if (kind == 2 || kind == 3) {
                    float q = 0.f;
#pragma unroll
                    for (int e = 0; e < 16; ++e) q += v[e] * v[e];
                    q += __shfl_xor(q, 16); q += __shfl_xor(q, 32);
                    const float r = rsqrtf(q * (1.0f / 64.0f) + EPS);
#pragma unroll
                    for (int e = 0; e < 16; ++e) v[e] = v[e] * r * gv[e];
                }
                u32x4 w0, w1;
                w0.x = pk2(v[0], v[1]); w0.y = pk2(v[2], v[3]); w0.z = pk2(v[4], v[5]); w0.w = pk2(v[6], v[7]);
                w1.x = pk2(v[8], v[9]); w1.y = pk2(v[10], v[11]); w1.z = pk2(v[12], v[13]); w1.w = pk2(v[14], v[15]);
                bf16_t* dp = dst + (size_t)row * 512 + colb;
                *(GAS u32x4*)dp = w0; *(GAS u32x4*)(dp + 8) = w1;
                if (want_out) {
                    long orow = -1;
                    if (row >= MP) orow = (long)layer * MS + (row - MP);
                    else { const int t = row & (SEQ - 1); if (t >= SEQ - PAST) orow = ((long)layer * NB + (row >> 12)) * PAST + (t - (SEQ - PAST)); }
                    if (orow >= 0) { float* op = ob + orow * 512 + colb;
                        float vo[16];
#pragma unroll
                        for (int e = 0; e < 16; ++e) vo[e] = (kind == 3) ? v[e] : v[e];
#pragma unroll
                        for (int e4 = 0; e4 < 4; ++e4) *(GAS f32x4*)(op + 4 * e4) = (f32x4){vo[4 * e4], vo[4 * e4 + 1], vo[4 * e4 + 2], vo[4 * e4 + 3]}; }
                }
            }
    }
};

struct EpiGlu {
    static constexpr bool PERM = false, AFTER_DRAIN = false;
    const bf16_t* SG; bf16_t* MIX;
    __device__ __forceinline__ void operator()(const f32x4 (&acc)[2][2][4][2], const Unit& u, int wr, int wc, int fr, int fq) const {
        const int col = u.pn * 128 + wc * 32 + fq * 8;
#pragma unroll
        for (int ai = 0; ai < 2; ++ai)
#pragma unroll
            for (int m = 0; m < 4; ++m) {
                const int row = u.pm * BM + ai * HALF + wr * 64 + m * 16 + fr;
                const u32x4 sg = *(const GAS u32x4*)(SG + (size_t)row * 512 + col);
                float o[8];
#pragma unroll
                for (int n = 0; n < 2; ++n)
#pragma unroll
                    for (int i = 0; i < 4; ++i) { const int e = 4 * n + i; const unsigned sw = sg[e >> 1]; const float s = bf2f((e & 1) ? (sw >> 16) : (sw & 0xffffu));
                        o[e] = acc[ai][0][m][n][i] * sigmoid_f(acc[ai][1][m][n][i]) * s; }
                u32x4 w; w.x = pk2(o[0], o[1]); w.y = pk2(o[2], o[3]); w.z = pk2(o[4], o[5]); w.w = pk2(o[6], o[7]);
                *(GAS u32x4*)(MIX + (size_t)row * 1024 + col) = w;
            }
    }
};

struct EpiOut {
    static constexpr bool PERM = false, AFTER_DRAIN = false;
    const float* resP; const float* resS; float* outP; float* outS; bf16_t* XB; float* rowss; int first;
    __device__ __forceinline__ void operator()(const f32x4 (&acc)[2][2][4][2], const Unit& u, int wr, int wc, int fr, int fq) const {
        const int col = u.pn * 256 + wc * 64 + fq * 16;
#pragma unroll
        for (int ai = 0; ai < 2; ++ai)
#pragma unroll
            for (int m = 0; m < 4; ++m) {
                const int row = u.pm * BM + ai * HALF + wr * 64 + m * 16 + fr;
                const float* rp = (row < MP) ? resP + (size_t)row * DM + col : resS + (size_t)(row - MP) * DM + col;
                float* op = (row < MP) ? outP + (size_t)row * DM + col : outS + (size_t)(row - MP) * DM + col;
                float y[16]; float ss = 0.f;
#pragma unroll
                for (int bj = 0; bj < 2; ++bj)
#pragma unroll
                    for (int n = 0; n < 2; ++n) { const f32x4 r = *(const GAS f32x4*)(rp + 8 * bj + 4 * n); const f32x4 t = r + acc[ai][bj][m][n];
                        *(GAS f32x4*)(op + 8 * bj + 4 * n) = t;
                        y[8 * bj + 4 * n] = t.x; y[8 * bj + 4 * n + 1] = t.y; y[8 * bj + 4 * n + 2] = t.z; y[8 * bj + 4 * n + 3] = t.w; }
                if (first) {
#pragma unroll
                    for (int e = 0; e < 16; ++e) ss += y[e] * y[e];
                    ss += __shfl_xor(ss, 16); ss += __shfl_xor(ss, 32);
                    u32x4 w0, w1;
                    w0.x = pk2(y[0], y[1]); w0.y = pk2(y[2], y[3]); w0.z = pk2(y[4], y[5]); w0.w = pk2(y[6], y[7]);
                    w1.x = pk2(y[8], y[9]); w1.y = pk2(y[10], y[11]); w1.z = pk2(y[12], y[13]); w1.w = pk2(y[14], y[15]);
                    bf16_t* xp = XB + (size_t)row * DM + col;
                    *(GAS u32x4*)xp = w0; *(GAS u32x4*)(xp + 8) = w1;
                    if (fq == 0) *(GAS float*)(rowss + (size_t)row * 16 + u.pn * 4 + wc) = ss;
                }
            }
    }
};

struct EpiPassA {
    static constexpr bool PERM = false, AFTER_DRAIN = true;
    const f32x2* a64; f32x2* hin; float* out; int layer;
    __device__ __forceinline__ void fused(const f32x4 (&acc)[2][2][4][2], const Unit& u, int wr, int wc, int fr, int fq, PG8_LAS unsigned char* lds, int wid, int lane) const {
        PG8_LAS float* S = (PG8_LAS float*)lds;
#pragma unroll
        for (int ai = 0; ai < 2; ++ai)
#pragma unroll
            for (int m = 0; m < 4; ++m) { const int r = ai * HALF + wr * 64 + m * 16 + fr;
#pragma unroll
                for (int n = 0; n < 2; ++n) *(PG8_LAS f32x4*)(S + r * 128 + wc * 32 + n * 16 + fq * 4) = acc[ai][0][m][n] + acc[ai][1][m][n]; }
        asm volatile("s_waitcnt lgkmcnt(0)" ::: "memory"); __builtin_amdgcn_s_barrier(); asm volatile("" ::: "memory");
        const int tid = wid * 64 + lane;
        if (tid < 256) {
            const int bl = tid >> 6, p = tid & 63, g = u.pm >> 2, b = (u.pm & 3) * 4 + bl;
            const f32x2 a = *(const GAS f32x2*)(a64 + g * 64 + p);
            float hr = 0.f, hi = 0.f;
            f32x2* hp = hin + ((size_t)(b * NCH) * NG + g) * NP + p;
            for (int c = 0; c < NCH; ++c) {
                const f32x2 s = *(const PG8_LAS f32x2*)(S + (bl * 64 + c) * 128 + 2 * p);
                *(GAS f32x2*)(hp + (size_t)c * NG * NP) = (f32x2){hr, hi};
                const float nr = a.x * hr - a.y * hi + s.x, ni = a.x * hi + a.y * hr + s.y;
                hr = nr; hi = ni;
            }
            const size_t o = ((size_t)(layer * NB + b) * NG + g) * NP + p;
            *(GAS float*)(out + O_RP + o) = hr; *(GAS float*)(out + O_IP + o) = hi;
        }
        asm volatile("s_waitcnt lgkmcnt(0)" ::: "memory"); __builtin_amdgcn_s_barrier(); asm volatile("" ::: "memory");
    }
};

template <class Epi, class Sched, class GP, bool ALIGN_EPI = false, bool SP2 = false>
__device__ __forceinline__ void gemm_phase(PG8_LAS unsigned char* lds, const GP& g, const Sched& S, const Epi& E) {
    int tid_ = threadIdx.x; asm volatile("" : "+v"(tid_));
    const int tid = tid_, wid = __builtin_amdgcn_readfirstlane(tid >> 6), lane = tid & 63, wr = wid >> 2, wc = wid & 3, fr = lane & 15, fq = lane >> 4;
    const int nt = g.nt();
    unsigned voffA[2], voffB[2];
#pragma unroll
    for (int i = 0; i < 2; ++i) { int R, C; stage_rc(tid * 16 + i * 8192, R, C); const int Rb = Epi::PERM ? ((R & ~31) + perm32(R & 31)) : R;
        voffA[i] = g.a_voff(R, C); voffB[i] = g.b_voff(Rb, C); }
    const size_t kstepA = g.a_kstep(), kstepB = g.b_kstep(), hstepA = g.a_hstep(), hstepB = g.b_hstep();
    const unsigned ldsw = (unsigned)wid * 1024u;
    const int aoff = lds_byte(wr * 64 + fr, fq * 8), boff = lds_byte(wc * 32 + fr, fq * 8);
#define PG8_SA(b, h) (((b) * 2 + (h)) * HTB)
#define PG8_SB(b, h) ((4 + (b) * 2 + (h)) * HTB)
#define PG8_STAGE(bufoff, gbase, voff) do { _Pragma("unroll") for (int _i = 0; _i < 2; ++_i) \
        __builtin_amdgcn_global_load_lds((const unsigned*)((const char*)(gbase) + (voff)[_i]), (PG8_LAS unsigned*)(lds + (bufoff) + ldsw + _i * 8192), 16, 0, 0); } while (0)
#define PG8_LDA(dst, b, h) do { _Pragma("unroll") for (int m = 0; m < 4; ++m) _Pragma("unroll") for (int k = 0; k < 2; ++k) dst[m][k] = *(const PG8_LAS bf16x8*)(lds + PG8_SA(b, h) + aoff + m * 2048 + k * 1024); } while (0)
#define PG8_LDB(dst, b, h) do { _Pragma("unroll") for (int n = 0; n < 2; ++n) _Pragma("unroll") for (int k = 0; k < 2; ++k) dst[n][k] = *(const PG8_LAS bf16x8*)(lds + PG8_SB(b, h) + boff + n * 2048 + k * 1024); } while (0)
#define PG8_MMA(ai, bj, At, Bt) do { __builtin_amdgcn_s_setprio(1); _Pragma("unroll") for (int m = 0; m < 4; ++m) _Pragma("unroll") for (int n = 0; n < 2; ++n) _Pragma("unroll") for (int k = 0; k < 2; ++k) \
        acc[ai][bj][m][n] = __builtin_amdgcn_mfma_f32_16x16x32_bf16(Bt[n][k], At[m][k], acc[ai][bj][m][n], 0, 0, 0); __builtin_amdgcn_s_setprio(0); } while (0)
#define PG8_WAIT_V(n) asm volatile("s_waitcnt vmcnt(" #n ")" ::: "memory")
#define PG8_WAIT_L(n) asm volatile("s_waitcnt lgkmcnt(" #n ")" ::: "memory")
#define PG8_BAR __builtin_amdgcn_s_barrier()
#define PG8_SCHED __builtin_amdgcn_sched_barrier(0)
    Unit cur, nxt; int ui = 0;
    if (!S.next(0, cur)) return;
    f32x4 acc[2][2][4][2];
#pragma unroll
    for (int a = 0; a < 2; ++a)
#pragma unroll
        for (int b = 0; b < 2; ++b)
#pragma unroll
            for (int m = 0; m < 4; ++m)
#pragma unroll
                for (int n = 0; n < 2; ++n) acc[a][b][m][n] = (f32x4){0.f, 0.f, 0.f, 0.f};
    bf16x8 At[4][2], B0[2][2], B1[2][2];
    const char* cA = g.a_base(cur); const char* cB = g.b_base(cur);
    S.a_ready(cur);
    if constexpr (SP2) {
        PG8_STAGE(PG8_SB(0, 0), cB, voffB); PG8_STAGE(PG8_SB(0, 1), cB + hstepB, voffB); PG8_STAGE(PG8_SA(0, 0), cA, voffA); PG8_STAGE(PG8_SA(0, 1), cA + hstepA, voffA);
        if (wr == 1) PG8_BAR;
        PG8_WAIT_V(2); PG8_BAR;
        PG8_STAGE(PG8_SB(1, 0), cB + kstepB, voffB); PG8_STAGE(PG8_SA(1, 0), cA + kstepA, voffA); PG8_STAGE(PG8_SB(1, 1), cB + hstepB + kstepB, voffB);
        PG8_WAIT_V(6); PG8_BAR;
    } else {
        PG8_STAGE(PG8_SB(0, 0), cB, voffB); PG8_STAGE(PG8_SA(0, 0), cA, voffA); PG8_STAGE(PG8_SB(0, 1), cB + hstepB, voffB); PG8_STAGE(PG8_SA(0, 1), cA + hstepA, voffA);
        if (wr == 1) PG8_BAR;
        PG8_WAIT_V(4); PG8_BAR;
        PG8_STAGE(PG8_SB(1, 0), cB + kstepB, voffB); PG8_STAGE(PG8_SA(1, 0), cA + kstepA, voffA); PG8_STAGE(PG8_SB(1, 1), cB + hstepB + kstepB, voffB);
        PG8_WAIT_V(6); PG8_BAR;
    }
    for (;;) {
        const bool has_next = S.next(ui + 1, nxt);
        const char* nA = has_next ? g.a_base(nxt) : cA; const char* nB = has_next ? g.b_base(nxt) : cB;
        for (int t = 0; t < nt; t += 2) {
            const bool last = (t == nt - 2);
            const char* a1 = cA + (size_t)(t + 1) * kstepA;
            const char* a2 = last ? nA : cA + (size_t)(t + 2) * kstepA; const char* b2 = last ? nB : cB + (size_t)(t + 2) * kstepB;
            const char* a3 = a2 + kstepA; const char* b3 = b2 + kstepB;
            if (last && has_next) S.a_ready(nxt);
            if constexpr (SP2) {
            PG8_LDB(B0, 0, 0); PG8_LDB(B1, 0, 1); PG8_SCHED; PG8_LDA(At, 0, 0); PG8_STAGE(PG8_SA(1, 1), a1 + hstepA, voffA);
            PG8_WAIT_V(8); PG8_WAIT_L(0); PG8_BAR; PG8_MMA(0, 0, At, B0); PG8_MMA(0, 1, At, B1); PG8_BAR; PG8_SCHED;
            PG8_LDA(At, 0, 1); PG8_STAGE(PG8_SB(0, 0), b2, voffB); PG8_STAGE(PG8_SB(0, 1), b2 + hstepB, voffB); PG8_STAGE(PG8_SA(0, 0), a2, voffA);
            PG8_WAIT_V(8); PG8_WAIT_L(0); PG8_BAR; PG8_MMA(1, 0, At, B0); PG8_MMA(1, 1, At, B1); PG8_BAR; PG8_SCHED;
            PG8_LDB(B0, 1, 0); PG8_LDB(B1, 1, 1); PG8_SCHED; PG8_LDA(At, 1, 0); PG8_STAGE(PG8_SA(0, 1), a2 + hstepA, voffA);
            PG8_WAIT_V(8); PG8_WAIT_L(0); PG8_BAR; PG8_MMA(0, 0, At, B0); PG8_MMA(0, 1, At, B1); PG8_BAR; PG8_SCHED;
            PG8_LDA(At, 1, 1); PG8_STAGE(PG8_SB(1, 0), b3, voffB); PG8_STAGE(PG8_SB(1, 1), b3 + hstepB, voffB); PG8_STAGE(PG8_SA(1, 0), a3, voffA);
            PG8_WAIT_V(8); PG8_WAIT_L(0); PG8_BAR; PG8_MMA(1, 0, At, B0); PG8_MMA(1, 1, At, B1); PG8_BAR; PG8_SCHED;
            } else {
            PG8_LDB(B0, 0, 0); PG8_SCHED; PG8_LDA(At, 0, 0); PG8_STAGE(PG8_SA(1, 1), a1 + hstepA, voffA);
            PG8_WAIT_L(8); PG8_BAR; PG8_WAIT_L(0); PG8_MMA(0, 0, At, B0); PG8_BAR; PG8_SCHED;
            PG8_LDB(B1, 0, 1); PG8_STAGE(PG8_SB(0, 0), b2, voffB);
            PG8_BAR; PG8_WAIT_L(0); PG8_MMA(0, 1, At, B1); PG8_BAR;
            PG8_LDA(At, 0, 1); PG8_STAGE(PG8_SA(0, 0), a2, voffA);
            PG8_BAR; PG8_WAIT_L(0); PG8_MMA(1, 0, At, B0); PG8_BAR; PG8_SCHED;
            PG8_STAGE(PG8_SB(0, 1), b2 + hstepB, voffB);
            PG8_WAIT_V(6); PG8_BAR; PG8_MMA(1, 1, At, B1); PG8_BAR;
            PG8_LDB(B0, 1, 0); PG8_SCHED; PG8_LDA(At, 1, 0); PG8_STAGE(PG8_SA(0, 1), a2 + hstepA, voffA);
            PG8_WAIT_L(8); PG8_BAR; PG8_WAIT_L(0); PG8_MMA(0, 0, At, B0); PG8_BAR; PG8_SCHED;
            PG8_LDB(B1, 1, 1); PG8_STAGE(PG8_SB(1, 0), b3, voffB);
            PG8_BAR; PG8_WAIT_L(0); PG8_MMA(0, 1, At, B1); PG8_BAR;
            PG8_LDA(At, 1, 1); PG8_STAGE(PG8_SA(1, 0), a3, voffA);
            PG8_BAR; PG8_WAIT_L(0); PG8_MMA(1, 0, At, B0); PG8_BAR; PG8_SCHED;
            PG8_STAGE(PG8_SB(1, 1), b3 + hstepB, voffB);
            PG8_WAIT_V(6); PG8_BAR; PG8_MMA(1, 1, At, B1); PG8_BAR;
            }
        }
        if constexpr (ALIGN_EPI) { if (wr == 0) PG8_BAR; }
        if constexpr (!Epi::AFTER_DRAIN) { E(acc, cur, wr, wc, fr, fq); S.done(cur); }
        if (!has_next) break;
#pragma unroll
        for (int a = 0; a < 2; ++a)
#pragma unroll
            for (int b = 0; b < 2; ++b)
#pragma unroll
                for (int m = 0; m < 4; ++m)
#pragma unroll
                    for (int n = 0; n < 2; ++n) acc[a][b][m][n] = (f32x4){0.f, 0.f, 0.f, 0.f};
        cur = nxt; cA = nA; cB = nB; ++ui;
        if constexpr (ALIGN_EPI) { if (wr == 1) PG8_BAR; }
    }
    PG8_WAIT_V(0);
    if constexpr (!ALIGN_EPI) { if (wr == 0) PG8_BAR; }
    PG8_BAR;
    if constexpr (Epi::AFTER_DRAIN) { E.fused(acc, cur, wr, wc, fr, fq, lds, wid, lane); S.done(cur); }
#undef PG8_SA
#undef PG8_SB
#undef PG8_STAGE
#undef PG8_LDA
#undef PG8_LDB
#undef PG8_MMA
#undef PG8_WAIT_V
#undef PG8_WAIT_L
#undef PG8_BAR
#undef PG8_SCHED
}
}
struct InPtrs { const float* p[21]; };
typedef const float* fptr_t;
typedef __attribute__((address_space(4))) const fptr_t* kargp_t;
__device__ __forceinline__ int rowmap_inout(int col) {
    const int a = col & 255, wc = a >> 6, fq = (a >> 4) & 3, bj = (a >> 3) & 1, n = (a >> 2) & 1, i = a & 3;
    return (col & ~255) + bj * 128 + wc * 32 + n * 16 + fq * 4 + i;
}
__device__ __forceinline__ int rowmap_glu(int c) {
    const int bj = c >> 9, j = c & 511, pn = j >> 7, jj = j & 127, wc = jj >> 5, fq = (jj >> 3) & 3, n = (jj >> 2) & 1, i = jj & 3;
    return pn * 256 + bj * 128 + wc * 32 + n * 16 + fq * 4 + i;
}
__device__ __forceinline__ void p0_transpose_item(const float* W, int K, int N, bf16_t* WT, int glu, const float* gain, LAS float* scr, int item, int lane) {
    const int nblk = N / 32, kb = item / nblk, nb = item % nblk, k0 = 64 * kb, n0 = 32 * nb;
#pragma unroll 8
    for (int i = 0; i < 32; ++i) { const int kk = 2 * i + (lane >> 5); float w = W[(size_t)(k0 + kk) * N + n0 + (lane & 31)]; if (gain) w *= gain[k0 + kk]; scr[kk * 33 + (lane & 31)] = w; }
    asm volatile("s_waitcnt lgkmcnt(0)" ::: "memory");
    const int c = lane & 7;
#pragma unroll
    for (int j = 0; j < 4; ++j) { const int n = (lane >> 3) + 8 * j; const LAS float* s = scr + (8 * c) * 33 + n;
        u32x4 o; o.x = pk2(s[0 * 33], s[1 * 33]); o.y = pk2(s[2 * 33], s[3 * 33]); o.z = pk2(s[4 * 33], s[5 * 33]); o.w = pk2(s[6 * 33], s[7 * 33]);
        const int dr = glu ? rowmap_glu(n0 + n) : rowmap_inout(n0 + n);
        *(u32x4*)(WT + (size_t)dr * K + k0 + 8 * c) = o; }
    asm volatile("s_waitcnt lgkmcnt(0)" ::: "memory");
}
__device__ __forceinline__ float wave_sum(float v) {
#pragma unroll
    for (int o = 1; o < 64; o <<= 1) v += __shfl_xor(v, o);
    return v;
}
struct Disc { double abr, abi, fr, fi, dt, ar, ai; };
__device__ __forceinline__ Disc s5_disc(kargp_t in, int l, int g, int p) {
    Disc d; d.ar = (double)in[8][(l * NG + g) * NP + p]; d.ai = (double)in[9][(l * NG + g) * NP + p]; d.dt = exp((double)in[15][l * NG + g]);
    const double mag = exp(d.dt * d.ar); double s, c; sincos(d.dt * d.ai, &s, &c);
    d.abr = mag * c; d.abi = mag * s;
    const double den = d.ar * d.ar + d.ai * d.ai, nr = d.abr - 1.0;
    d.fr = (nr * d.ar + d.abi * d.ai) / den; d.fi = (d.abi * d.ar - nr * d.ai) / den;
    return d;
}
__device__ __forceinline__ int crow(int r, int hi) { return (r & 3) + 8 * (r >> 2) + 4 * hi; }

__device__ __forceinline__ void p0_prologue(unsigned char* ws, LAS unsigned char* lds, int vcu, int G, int tid) {
    const int lane = tid & 63, wave = tid >> 6;
    kargp_t in = (kargp_t)__builtin_amdgcn_kernarg_segment_ptr(); asm volatile("" : "+s"(in));
    LAS float* scr = (LAS float*)(lds + wave * 16384);
    const int gw = vcu * 8 + wave, NGW = G * 8;
    constexpr int I_IN = (DM / 64) * (DIN / 32), I_GLU = (DS / 64) * (2 * DS / 32), I_OUT = (DM / 64) * (DM / 32), I_L = I_IN + I_GLU + I_OUT;
    for (int it = gw; it < NL * I_L; it += NGW) {
        const int l = it / I_L; int r = it % I_L;
        if (r < I_IN) { p0_transpose_item(in[7] + (size_t)l * DM * DIN, DM, DIN, (bf16_t*)(ws + WS_WIN + l * WIN_L), 0, in[6] + l * DM, scr, r, lane); continue; } r -= I_IN;
        if (r < I_GLU) { p0_transpose_item(in[16] + (size_t)l * DS * 2 * DS, DS, 2 * DS, (bf16_t*)(ws + WS_WGLU + l * WGLU_L), 1, nullptr, scr, r, lane); continue; } r -= I_GLU;
        p0_transpose_item(in[20] + (size_t)l * DM * DM, DM, DM, (bf16_t*)(ws + WS_WOUT + l * WOUT_L), 0, nullptr, scr, r, lane);
    }
    asm volatile("" : "+s"(in), "+s"(ws));
    {
        bf16_t* XB = (bf16_t*)(ws + WS_XB); float* rowss = (float*)(ws + WS_ROWSS);
        for (int m = gw; m < MT; m += NGW) {
            const float* xr = (m < MP) ? in[0] + (size_t)m * DM : in[1] + (size_t)(m - MP) * DM;
            f32x4 v[4]; float s = 0.f;
#pragma unroll
            for (int j = 0; j < 4; ++j) { v[j] = *(const f32x4*)(xr + 4 * lane + 256 * j); s += (v[j].x * v[j].x + v[j].y * v[j].y) + (v[j].z * v[j].z + v[j].w * v[j].w); }
            s = wave_sum(s);
#pragma unroll
            for (int j = 0; j < 4; ++j) { u32x2 o; o.x = pk2(v[j].x, v[j].y); o.y = pk2(v[j].z, v[j].w); *(u32x2*)(XB + (size_t)m * DM + 4 * lane + 256 * j) = o; }
            if (lane < 16) rowss[(size_t)m * 16 + lane] = (lane == 0) ? s : 0.f;
        }
    }
    asm volatile("" : "+s"(in), "+s"(ws));
    const int gt = vcu * 512 + tid, NGT = G * 512;
    for (int it = gt; it < NL * NG * NP; it += NGT) {
        const int l = it / (NG * NP), g = (it / NP) % NG, p = it % NP;
        const Disc d = s5_disc(in, l, g, p);
        unsigned char* tb = ws + WS_TAB + l * TAB_L;
        ((f32x2*)(tb + T_AB))[g * NP + p] = (f32x2){(float)d.abr, (float)d.abi};
        const double m64 = exp(64.0 * d.dt * d.ar); double s, c; sincos(64.0 * d.dt * d.ai, &s, &c);
        ((f32x2*)(tb + T_A64))[g * NP + p] = (f32x2){(float)(m64 * c), (float)(m64 * s)};
    }
    asm volatile("" : "+s"(in), "+s"(ws));
    for (int it = gt; it < NL * NG * 8 * 64; it += NGT) {
        const int l = it / (NG * 512), g = (it / 512) % NG, cb = (it / 64) % 8, ln = it % 64;
        const int p = 16 * (cb >> 1) + (ln & 15), ri = cb & 1;
        const Disc d = s5_disc(in, l, g, p);
        unsigned short o[8];
#pragma unroll
        for (int j = 0; j < 8; ++j) { const int k = 8 * (ln >> 4) + j, h = k & 15;
            const double br = (double)in[10][((size_t)(l * NG + g) * NP + p) * NCHN + h], bi = (double)in[11][((size_t)(l * NG + g) * NP + p) * NCHN + h];
            const float val = (float)(ri ? (d.fr * bi + d.fi * br) : (d.fr * br - d.fi * bi));
            const unsigned hi = f2bf(val); const unsigned lo = f2bf(val - bf2f(hi));
            o[j] = (unsigned short)(k < 16 ? hi : lo); }
        u32x4 w; w.x = o[0] | (o[1] << 16); w.y = o[2] | (o[3] << 16); w.z = o[4] | (o[5] << 16); w.w = o[6] | (o[7] << 16);
        ((u32x4*)(ws + WS_TAB + l * TAB_L + T_BU))[(g * 8 + cb) * 64 + ln] = w;
    }
    asm volatile("" : "+s"(in), "+s"(ws));
    for (int it = gt; it < NL * NG * 5 * 64; it += NGT) {
        const int l = it / (NG * 320), g = (it / 320) % NG, kb = (it / 64) % 5, ln = it % 64, h = ln & 15;
        unsigned short o[8];
        if (kb == 4) { const float dv = in[14][(l * NG + g) * NCHN + h]; const unsigned hi = f2bf(dv), lo = f2bf(dv - bf2f(hi));
#pragma unroll
            for (int j = 0; j < 8; ++j) { const int k = 8 * (ln >> 4) + j; o[j] = (unsigned short)(((k & 15) == h) ? (k < 16 ? hi : lo) : 0u); }
            u32x4 w; w.x = o[0] | (o[1] << 16); w.y = o[2] | (o[3] << 16); w.z = o[4] | (o[5] << 16); w.w = o[6] | (o[7] << 16);
            ((u32x4*)(ws + WS_TAB + l * TAB_L + T_D))[g * 64 + ln] = w;
        } else {
#pragma unroll
            for (int j = 0; j < 8; ++j) { const int kk = 8 * (ln >> 4) + j, p = 16 * kb + (kk >> 1), ri = kk & 1;
                const size_t ci = ((size_t)(l * NG + g) * NCHN + h) * NP + p;
                const float val = ri ? -in[13][ci] : in[12][ci]; o[j] = (unsigned short)f2bf(val); }
            u32x4 w; w.x = o[0] | (o[1] << 16); w.y = o[2] | (o[3] << 16); w.z = o[4] | (o[5] << 16); w.w = o[6] | (o[7] << 16);
            ((u32x4*)(ws + WS_TAB + l * TAB_L + T_C))[(g * 4 + kb) * 64 + ln] = w;
        }
    }
    asm volatile("" : "+s"(in), "+s"(ws));
    for (int it = gt; it < NL * NG * NP * 64; it += NGT) {
        const int l = it / (NG * NP * 64), g = (it / (NP * 64)) % NG, p = (it / 64) % NP, s = it % 64;
        const Disc d = s5_disc(in, l, g, p);
        const double n = (double)(63 - s), mg = exp(n * d.dt * d.ar); double sn, cs; sincos(n * d.dt * d.ai, &sn, &cs);
        const double wr = mg * cs, wi = mg * sn;
        const double zr = wr * d.fr - wi * d.fi, zi = wr * d.fi + wi * d.fr;
        unsigned short orh[16], oih[16], orl[16], oil[16];
#pragma unroll
        for (int h = 0; h < 16; ++h) {
            const double br = (double)in[10][((size_t)(l * NG + g) * NP + p) * NCHN + h], bi = (double)in[11][((size_t)(l * NG + g) * NP + p) * NCHN + h];
            const float vr = (float)(zr * br - zi * bi), vi = (float)(zr * bi + zi * br);
            const unsigned hr = f2bf(vr), hi = f2bf(vi);
            orh[h] = (unsigned short)hr; oih[h] = (unsigned short)hi; orl[h] = (unsigned short)f2bf(vr - bf2f(hr)); oil[h] = (unsigned short)f2bf(vi - bf2f(hi));
        }
        bf16_t* pm = (bf16_t*)(ws + WS_PM + l * PM_L) + (size_t)g * 256 * 1024 + 16 * s;
#pragma unroll
        for (int q = 0; q < 2; ++q) {
            u32x4 a, b, c, e;
            a.x = orh[8*q] | (orh[8*q+1] << 16); a.y = orh[8*q+2] | (orh[8*q+3] << 16); a.z = orh[8*q+4] | (orh[8*q+5] << 16); a.w = orh[8*q+6] | (orh[8*q+7] << 16);
            b.x = oih[8*q] | (oih[8*q+1] << 16); b.y = oih[8*q+2] | (oih[8*q+3] << 16); b.z = oih[8*q+4] | (oih[8*q+5] << 16); b.w = oih[8*q+6] | (oih[8*q+7] << 16);
            c.x = orl[8*q] | (orl[8*q+1] << 16); c.y = orl[8*q+2] | (orl[8*q+3] << 16); c.z = orl[8*q+4] | (orl[8*q+5] << 16); c.w = orl[8*q+6] | (orl[8*q+7] << 16);
            e.x = oil[8*q] | (oil[8*q+1] << 16); e.y = oil[8*q+2] | (oil[8*q+3] << 16); e.z = oil[8*q+4] | (oil[8*q+5] << 16); e.w = oil[8*q+6] | (oil[8*q+7] << 16);
            *(u32x4*)(pm + (size_t)(2 * p) * 1024 + 8 * q) = a; *(u32x4*)(pm + (size_t)(2 * p + 1) * 1024 + 8 * q) = b;
            *(u32x4*)(pm + (size_t)(128 + 2 * p) * 1024 + 8 * q) = c; *(u32x4*)(pm + (size_t)(128 + 2 * p + 1) * 1024 + 8 * q) = e;
        }
    }
    asm volatile("" : "+s"(in), "+s"(ws));
    for (int it = gt; it < NL * NH * 4 * 2 * 2 * 64; it += NGT) {
        const int l = it / (NH * 1024), h = (it / 1024) % NH, v = (it / 256) % 4, qh = (it / 128) % 2, pp = (it / 64) % 2, ln = it % 64;
        const float* tab = in[19] + (size_t)(l * NH + h) * NREL;
        const int j = (v == 3) ? 8 : 6 + v, q = 32 * qh + (ln & 31), hi = ln >> 5;
        float o[16];
#pragma unroll
        for (int r = 0; r < 16; ++r) { const int kk = crow(r, hi) + 32 * pp; int dist = q + 512 - 64 * j - kk; dist = dist < -128 ? -128 : (dist > 128 ? 128 : dist);
            o[r] = (v == 3 && kk >= 16) ? -1e30f : (tab[dist + 128] - tab[256]) * LOG2E; }
        float* bp = (float*)(ws + WS_TAB + l * TAB_L + T_BIAS) + ((size_t)(((h * 4 + v) * 2 + qh) * 2 + pp) * 64 + ln) * 16;
#pragma unroll
        for (int r4 = 0; r4 < 4; ++r4) *(f32x4*)(bp + 4 * r4) = (f32x4){o[4 * r4], o[4 * r4 + 1], o[4 * r4 + 2], o[4 * r4 + 3]};
    }
}
namespace att {
constexpr int LK = 0, LV = 32768, LWS = 65536, LOST = LWS + 8 * 256, LEND = LOST + 8 * 4096;
__device__ __forceinline__ s16x4 vtr(const LAS unsigned char* p) { return __builtin_bit_cast(s16x4, __builtin_amdgcn_ds_read_tr16_b64_v4i16((LAS s16x4*)p)); }
__device__ __forceinline__ unsigned cvtpk(float lo, float hi) { return pk2(lo, hi); }

struct Ctx { const GAS unsigned char* ws; const GAS float* cache_k; const GAS float* cache_v; int layer; };

__device__ __forceinline__ void unit(const Ctx& C, LAS unsigned char* lds, int type, int seq, int n, int hg, int tid) {
    const int lane = tid & 63, wid = tid >> 6, r32 = lane & 31, hi = lane >> 5, hh = wid >> 1, qh = wid & 1, head = hg * 4 + hh;
    const GAS bf16_t* Q = (const GAS bf16_t*)(C.ws + WS_Q); const GAS bf16_t* K = (const GAS bf16_t*)(C.ws + WS_K); const GAS bf16_t* V = (const GAS bf16_t*)(C.ws + WS_V);
    const GAS bf16_t* SGA = (const GAS bf16_t*)(C.ws + WS_SGA); GAS bf16_t* MIX = (GAS bf16_t*)(C.ws + WS_MIX);
    const GAS float* BIAS = (const GAS float*)(C.ws + WS_TAB + (size_t)C.layer * TAB_L + T_BIAS);
    const long qrow0 = type == 0 ? (long)seq * SEQ + n * 64 + qh * 32 : (long)MP + seq * SSEQ;
    const bool wave_valid = (type == 0) || (qh == 0);
    const bool row_valid = (type == 0) || (qh == 0 && r32 < SSEQ);
    bf16x8 qr[4];
#pragma unroll
    for (int d0 = 0; d0 < 4; ++d0) { qr[d0] = (bf16x8){0, 0, 0, 0, 0, 0, 0, 0}; if (row_valid) qr[d0] = *(const GAS bf16x8*)(Q + (qrow0 + r32) * 512 + head * 64 + d0 * 16 + hi * 8); }
    float m_run = -1.0e30f, l_run = 0.f; f32x16 o[2]; o[0] = f32x16{}; o[1] = f32x16{};
    LAS float* wsf = (LAS float*)(lds + LWS) + wid * 64;
    const int jstart = (type == 0 && n < 8) ? 8 - n : 0;
    for (int j = jstart; j < 9; ++j) {
        __syncthreads();
        if (type == 0 || j == 8) {
            const long krow0 = type == 0 ? (long)seq * SEQ + (long)(n - 8 + j) * 64 : (long)MP + seq * SSEQ;
#pragma unroll
            for (int i = 0; i < 4; ++i) {
                const int idx = tid + 512 * i;
                { const int row = idx & 63, ch = (idx >> 6) & 7, h4 = idx >> 9; u32x4 v = (u32x4){0u, 0u, 0u, 0u};
                  if (type == 0 || row < SSEQ) v = *(const GAS u32x4*)(K + (krow0 + row) * 512 + (hg * 4 + h4) * 64 + ch * 8);
                  *(LAS u32x4*)(lds + LK + idx * 16) = v; }
                { const int h4 = idx >> 9, e = idx & 511, w8 = e >> 6, ln = e & 63, row = 16 * (w8 & 3) + (ln >> 2), dh = w8 >> 2, c16 = ln & 3; u32x4 v = (u32x4){0u, 0u, 0u, 0u};
                  if (type == 0 || row < SSEQ) v = *(const GAS u32x4*)(V + (krow0 + row) * 512 + (hg * 4 + h4) * 64 + dh * 32 + c16 * 8);
                  *(LAS u32x4*)(lds + LV + idx * 16) = v; }
            }
        } else {
            const GAS float* ck = C.cache_k + ((size_t)(C.layer * SBAT + seq) * PAST + 64 * j) * (NH * HD);
            const GAS float* cv = C.cache_v + ((size_t)(C.layer * SBAT + seq) * PAST + 64 * j) * (NH * HD);
#pragma unroll
            for (int i = 0; i < 4; ++i) {
                const int idx = tid + 512 * i;
                { const int row = idx & 63, ch = (idx >> 6) & 7, h4 = idx >> 9; const GAS float* p = ck + (size_t)row * (NH * HD) + (hg * 4 + h4) * 64 + ch * 8;
                  const f32x4 a = *(const GAS f32x4*)p, b = *(const GAS f32x4*)(p + 4);
                  *(LAS u32x4*)(lds + LK + idx * 16) = (u32x4){pk2(a.x, a.y), pk2(a.z, a.w), pk2(b.x, b.y), pk2(b.z, b.w)}; }
                { const int h4 = idx >> 9, e = idx & 511, w8 = e >> 6, ln = e & 63, row = 16 * (w8 & 3) + (ln >> 2), dh = w8 >> 2, c16 = ln & 3;
                  const GAS float* p = cv + (size_t)row * (NH * HD) + (hg * 4 + h4) * 64 + dh * 32 + c16 * 8;
                  const f32x4 a = *(const GAS f32x4*)p, b = *(const GAS f32x4*)(p + 4);
                  *(LAS u32x4*)(lds + LV + idx * 16) = (u32x4){pk2(a.x, a.y), pk2(a.z, a.w), pk2(b.x, b.y), pk2(b.z, b.w)}; }
            }
        }
        __syncthreads();
        if (!wave_valid) continue;
        f32x16 p0 = f32x16{}, p1 = f32x16{};
        if (j >= 6) {
            const int v = (type == 1 && j == 8) ? 3 : j - 6;
            const GAS float* bp = BIAS + ((size_t)(((head * 4 + v) * 2 + qh) * 2) * 64 + lane) * 16;
#pragma unroll
            for (int r4 = 0; r4 < 4; ++r4) { const f32x4 a = *(const GAS f32x4*)(bp + 4 * r4), b = *(const GAS f32x4*)(bp + 1024 + 4 * r4);
                p0[4 * r4] = a.x; p0[4 * r4 + 1] = a.y; p0[4 * r4 + 2] = a.z; p0[4 * r4 + 3] = a.w; p1[4 * r4] = b.x; p1[4 * r4 + 1] = b.y; p1[4 * r4 + 2] = b.z; p1[4 * r4 + 3] = b.w; }
        }
        const LAS unsigned char* kb = lds + LK + hh * 8192 + hi * 1024 + r32 * 16;
#pragma unroll
        for (int d0 = 0; d0 < 4; ++d0) {
            const bf16x8 k0 = *(const LAS bf16x8*)(kb + d0 * 2048), k1 = *(const LAS bf16x8*)(kb + d0 * 2048 + 512);
            p0 = __builtin_amdgcn_mfma_f32_32x32x16_bf16(k0, qr[d0], p0, 0, 0, 0);
            p1 = __builtin_amdgcn_mfma_f32_32x32x16_bf16(k1, qr[d0], p1, 0, 0, 0);
        }
        float rm = p0[0];
#pragma unroll
        for (int r = 1; r < 16; ++r) rm = fmaxf(rm, p0[r]);
#pragma unroll
        for (int r = 0; r < 16; ++r) rm = fmaxf(rm, p1[r]);
        rm = fmaxf(rm, __shfl_xor(rm, 32));
        const float mn = fmaxf(m_run, rm), alpha = __builtin_amdgcn_exp2f(m_run - mn);
        m_run = mn;
        float ls = 0.f;
#pragma unroll
        for (int r = 0; r < 16; ++r) { p0[r] = __builtin_amdgcn_exp2f(p0[r] - mn); p1[r] = __builtin_amdgcn_exp2f(p1[r] - mn); ls += p0[r] + p1[r]; }
        l_run = l_run * alpha + ls;
        if (hi == 0) wsf[r32] = alpha;
        asm volatile("s_waitcnt lgkmcnt(0)" ::: "memory");
#pragma unroll
        for (int r = 0; r < 16; ++r) { const float al = wsf[crow(r, hi)]; o[0][r] *= al; o[1][r] *= al; }
        u32x4 pw[4];
#pragma unroll
        for (int q4 = 0; q4 < 4; ++q4) { pw[0][q4] = cvtpk(p0[2 * q4], p0[2 * q4 + 1]); pw[1][q4] = cvtpk(p0[8 + 2 * q4], p0[8 + 2 * q4 + 1]); pw[2][q4] = cvtpk(p1[2 * q4], p1[2 * q4 + 1]); pw[3][q4] = cvtpk(p1[8 + 2 * q4], p1[8 + 2 * q4 + 1]); }
        const LAS unsigned char* vb = lds + LV + hh * 8192 + ((lane >> 4) & 1) * 32 + (lane & 3) * 8 + (4 * hi + ((lane & 15) >> 2)) * 64;
#pragma unroll
        for (int d0 = 0; d0 < 2; ++d0)
#pragma unroll
            for (int ks = 0; ks < 4; ++ks) {
                const s16x4 lo = vtr(vb + d0 * 4096 + ks * 1024), hv = vtr(vb + d0 * 4096 + ks * 1024 + 512);
                const bf16x8 vf = (bf16x8){lo[0], lo[1], lo[2], lo[3], hv[0], hv[1], hv[2], hv[3]};
                o[d0] = __builtin_amdgcn_mfma_f32_32x32x16_bf16(__builtin_bit_cast(bf16x8, pw[ks]), vf, o[d0], 0, 0, 0);
            }
    }
    if (wave_valid) {
        const float lt = l_run + __shfl_xor(l_run, 32);
        asm volatile("s_waitcnt lgkmcnt(0)" ::: "memory");
        if (hi == 0) wsf[32 + r32] = lt;
        asm volatile("s_waitcnt lgkmcnt(0)" ::: "memory");
        LAS bf16_t* stg = (LAS bf16_t*)(lds + LOST) + wid * 2048;
#pragma unroll
        for (int r = 0; r < 16; ++r) { const int orow = crow(r, hi); const float rl = 1.0f / wsf[32 + orow];
            stg[orow * 64 + r32] = (bf16_t)f2bf(o[0][r] * rl); stg[orow * 64 + 32 + r32] = (bf16_t)f2bf(o[1][r] * rl); }
        asm volatile("s_waitcnt lgkmcnt(0)" ::: "memory");
#pragma unroll
        for (int i = 0; i < 4; ++i) { const int row = i * 8 + (lane >> 3), ch = lane & 7;
            if (type == 0 || row < SSEQ) {
                const u32x4 ov = *(const LAS u32x4*)(stg + row * 64 + ch * 8);
                const u32x4 gv = *(const GAS u32x4*)(SGA + (qrow0 + row) * 512 + head * 64 + ch * 8);
                u32x4 w;
#pragma unroll
                for (int c = 0; c < 4; ++c) { const float a0 = bf2f(ov[c] & 0xffffu) * bf2f(gv[c] & 0xffffu), a1 = bf2f(ov[c] >> 16) * bf2f(gv[c] >> 16); w[c] = pk2(a0, a1); }
                *(GAS u32x4*)(MIX + (qrow0 + row) * 1024 + 512 + head * 64 + ch * 8) = w; } }
    }
}

__device__ __forceinline__ void phase(const Ctx& C, LAS unsigned char* lds, GAS unsigned* qctr, int bx, int tid) {
    LAS unsigned* bc = (LAS unsigned*)(lds + 131072 + 1024);
    for (int dq = 0; dq < 8; ++dq) {
        const int x = (bx + dq) & 7;
        for (;;) {
            __syncthreads();
            if (tid == 0) bc[0] = __hip_atomic_fetch_add(qctr + x * 64, 1u, __ATOMIC_RELAXED, __HIP_MEMORY_SCOPE_AGENT);
            __syncthreads();
            const unsigned idx = bc[0];
            if (idx >= 264u) break;
            int type, seq, n, hg;
            if (idx < 8u) { type = 1; seq = 4 * x + (int)(idx >> 1); n = 0; hg = (int)(idx & 1); }
            else { const int k = (int)idx - 8, sq = 4 * x + (k >> 6); type = 0; seq = sq >> 1; n = k & 63; hg = sq & 1; }
            unit(C, lds, type, seq, n, hg, tid);
        }
    }
}
}
namespace s5 {
constexpr int HKB = 1040;
constexpr int WLDS = 8192 + 4 * HKB;
static_assert(8 * WLDS <= 131072, "s5 lds");
struct Ctx { const GAS unsigned char* ws; const GAS float* st_re; const GAS float* st_im; GAS float* out; int layer; };

__device__ __forceinline__ void unit(const Ctx& C, LAS unsigned char* wl, int type, int seq, int c, int g, int lane) {
    const int fr = lane & 15, fq = lane >> 4;
    const GAS unsigned char* tb = C.ws + WS_TAB + (size_t)C.layer * TAB_L;
    const GAS bf16_t* U = (const GAS bf16_t*)(C.ws + WS_U); GAS bf16_t* YG = (GAS bf16_t*)(C.ws + WS_YG);
    bf16x8 bu[8], cm[4], dmat;
#pragma unroll
    for (int cb = 0; cb < 8; ++cb) bu[cb] = *(const GAS bf16x8*)(tb + T_BU + ((size_t)(g * 8 + cb) * 64 + lane) * 16);
#pragma unroll
    for (int kb = 0; kb < 4; ++kb) cm[kb] = *(const GAS bf16x8*)(tb + T_C + ((size_t)(g * 4 + kb) * 64 + lane) * 16);
    dmat = *(const GAS bf16x8*)(tb + T_D + ((size_t)g * 64 + lane) * 16);
    const f32x2 ab = *(const GAS f32x2*)(tb + T_AB + ((size_t)g * 64 + lane) * 8);
    float hr, hi; long row0; int nrb;
    if (type == 0) { const f32x2 h0 = *(const GAS f32x2*)(C.ws + WS_HIN + ((((size_t)seq * NCH + c) * NG + g) * NP + lane) * 8); hr = h0.x; hi = h0.y; row0 = (long)seq * SEQ + c * 64; nrb = 4; }
    else { const size_t si = ((size_t)(C.layer * SBAT + seq) * NG + g) * NP + lane; hr = C.st_re[si]; hi = C.st_im[si]; row0 = (long)MP + seq * SSEQ; nrb = 1; }
    LAS unsigned char* hb = wl + 8192;
    for (int rb = 0; rb < nrb; ++rb) {
        const bf16x8 ua = *(const GAS bf16x8*)(U + (row0 + rb * 16 + fr) * 512 + g * 16 + (fq & 1) * 8);
#pragma unroll
        for (int j = 0; j < 4; ++j) {
            const f32x4 z = {0.f, 0.f, 0.f, 0.f};
            const f32x4 re = __builtin_amdgcn_mfma_f32_16x16x32_bf16(ua, bu[2 * j], z, 0, 0, 0);
            const f32x4 im = __builtin_amdgcn_mfma_f32_16x16x32_bf16(ua, bu[2 * j + 1], z, 0, 0, 0);
#pragma unroll
            for (int r = 0; r < 4; ++r) *(LAS f32x2*)(wl + (4 * fq + r) * 512 + (16 * j + fr) * 8) = (f32x2){re[r], im[r]};
        }
#pragma unroll
        for (int t = 0; t < 16; ++t) {
            const f32x2 b = *(const LAS f32x2*)(wl + t * 512 + lane * 8);
            const float nr = ab.x * hr - ab.y * hi + b.x, ni = ab.x * hi + ab.y * hr + b.y;
            hr = nr; hi = ni;
            *(LAS unsigned*)(hb + (lane >> 4) * HKB + t * 64 + (lane & 15) * 4) = pk2(hr, hi);
        }
        f32x4 y = {0.f, 0.f, 0.f, 0.f};
#pragma unroll
        for (int kb = 0; kb < 4; ++kb) { const bf16x8 ha = *(const LAS bf16x8*)(hb + kb * HKB + fr * 64 + fq * 16); y = __builtin_amdgcn_mfma_f32_16x16x32_bf16(ha, cm[kb], y, 0, 0, 0); }
        y = __builtin_amdgcn_mfma_f32_16x16x32_bf16(ua, dmat, y, 0, 0, 0);
#pragma unroll
        for (int r = 0; r < 4; ++r) YG[(row0 + rb * 16 + 4 * fq + r) * 512 + g * 16 + fr] = (bf16_t)f2bf(gelu_tanh(y[r]));
    }
    if (type == 1) { const size_t o = ((size_t)(C.layer * SBAT + seq) * NG + g) * NP + lane; C.out[O_RS + o] = hr; C.out[O_IS + o] = hi; }
}
__device__ __forceinline__ void phase(const Ctx& C, LAS unsigned char* lds, int vcu, int G, int tid) {
    const int lane = tid & 63, wave = __builtin_amdgcn_readfirstlane(tid >> 6);
    LAS unsigned char* wl = lds + wave * WLDS;
    const int gw = vcu * 8 + wave, NGW = G * 8;
    for (int u = gw; u < NB * NCH * NG + SBAT * NG; u += NGW) {
        if (u < NB * NCH * NG) unit(C, wl, 0, u >> 11, (u >> 5) & 63, u & 31, lane);
        else { const int v = u - NB * NCH * NG; unit(C, wl, 1, v >> 5, 0, v & 31, lane); }
    }
}
}
#ifndef PHMASK
#define PHMASK 0xFF
#endif
constexpr int LDS_BYTES = 147456;
constexpr int NPHASE = 1 + 5 * NL;
struct Args { InPtrs in; float* out; unsigned char* ws; int ph_lo, ph_hi; };

template <bool COOP>
__global__ void __launch_bounds__(512, 2) fwd(Args a) {
    extern __shared__ __attribute__((aligned(16))) unsigned char lds_raw[];
    LAS unsigned char* lds = (LAS unsigned char*)lds_raw;
    const int tid = threadIdx.x, G = gridDim.x, bx = blockIdx.x;
    const int vcu = (G % 8 == 0) ? (bx % 8) * (G / 8) + bx / 8 : bx;
    if (a.ph_lo == 0) {
        unsigned char* ws = a.ws; asm volatile("" : "+s"(ws));
        p0_prologue(ws, lds, vcu, G, tid);
        if (a.ph_hi > 1) { if constexpr (COOP) { cg::this_grid().sync(); } }
    }
    for (int ph = (a.ph_lo < 1 ? 1 : a.ph_lo); ph < a.ph_hi; ++ph) {
        unsigned char* ws = a.ws; float* out = a.out; asm volatile("" : "+s"(ws), "+s"(out));
        {
            const int l = (ph - 1) / 5, k = (ph - 1) % 5;
            if (k == 0 && (PHMASK & 2)) {
                pg8::GemmStd g{(const char*)(ws + WS_XB), (const char*)(ws + WS_WIN + l * WIN_L), DM};
                pg8::StaticOrder S; S.init(MT, DIN, G, bx);
                pg8::EpiInProj E{(const float*)(ws + WS_ROWSS), ws, a.in.p[17] + l * HD, a.in.p[18] + l * HD, out, l};
                pg8::gemm_phase<pg8::EpiInProj, pg8::StaticOrder, pg8::GemmStd, true, true>(lds, g, S, E);
            } else if (k == 1 && (PHMASK & 4)) {
                int tid_ = threadIdx.x; asm volatile("" : "+v"(tid_));
                {
                    pg8::GemmPassA g{(const char*)(ws + WS_U), (const char*)(ws + WS_PM + l * PM_L)};
                    pg8::OneUnitOrder S{NG * 4, bx};
                    pg8::EpiPassA E{(const f32x2*)(ws + WS_TAB + l * TAB_L + T_A64), (f32x2*)(ws + WS_HIN), out, l};
                    pg8::gemm_phase<pg8::EpiPassA, pg8::OneUnitOrder, pg8::GemmPassA, false, true>(lds, g, S, E);
                }
                att::Ctx C{(const GAS unsigned char*)ws, (const GAS float*)a.in.p[2], (const GAS float*)a.in.p[3], l};
                att::phase(C, lds, (GAS unsigned*)(ws + WS_CTL) + CW_QUEUE + l * 512, bx, tid_);
            } else if (k == 2 && (PHMASK & 8)) {
                int tid_ = threadIdx.x; asm volatile("" : "+v"(tid_));
                s5::Ctx C{(const GAS unsigned char*)ws, (const GAS float*)a.in.p[4], (const GAS float*)a.in.p[5], (GAS float*)out, l};
                s5::phase(C, lds, vcu, G, tid_);
            } else if (k == 3 && (PHMASK & 16)) {
                pg8::GemmStd g{(const char*)(ws + WS_YG), (const char*)(ws + WS_WGLU + l * WGLU_L), DS};
                pg8::StaticOrder S; S.init(MT, 2 * DS, G, bx);
                pg8::EpiGlu E{(const bf16_t*)(ws + WS_SG), (bf16_t*)(ws + WS_MIX)};
                pg8::gemm_phase<pg8::EpiGlu, pg8::StaticOrder, pg8::GemmStd, true, true>(lds, g, S, E);
            } else if (k == 4 && (PHMASK & 32)) {
                pg8::GemmStd g{(const char*)(ws + WS_MIX), (const char*)(ws + WS_WOUT + l * WOUT_L), DM};
                pg8::StaticOrder S; S.init(MT, DM, G, bx);
                pg8::EpiOut E{l == 0 ? a.in.p[0] : out + O_YP, l == 0 ? a.in.p[1] : out + O_YS, out + O_YP, out + O_YS, (bf16_t*)(ws + WS_XB), (float*)(ws + WS_ROWSS), l == 0 ? 1 : 0};
                pg8::gemm_phase<pg8::EpiOut, pg8::StaticOrder, pg8::GemmStd, true, true>(lds, g, S, E);
            }
        }
        if (ph + 1 < a.ph_hi) { if constexpr (COOP) { cg::this_grid().sync(); } }
    }
}

#ifndef MK_ONE_LAUNCH
#define MK_ONE_LAUNCH 1
#endif
extern "C" void kernel_launch(void* const* d_in, const int* in_sizes, int n_in, void* d_out, int out_size, void* d_ws, size_t ws_size, hipStream_t stream) {
    static int grid = 0;
    if (grid == 0) {
        if (n_in != 21 || (size_t)out_size != O_END || ws_size < WS_END) { fprintf(stderr, "kernel_launch: unexpected shapes (n_in %d out %d ws %zu)\n", n_in, out_size, ws_size); grid = -1; return; }
        int dev = 0, cus = 0, per_cu = 0;
        (void)hipGetDevice(&dev); (void)hipDeviceGetAttribute(&cus, hipDeviceAttributeMultiprocessorCount, dev);
        (void)hipFuncSetAttribute((const void*)fwd<false>, hipFuncAttributeMaxDynamicSharedMemorySize, LDS_BYTES);
        (void)hipFuncSetAttribute((const void*)fwd<true>, hipFuncAttributeMaxDynamicSharedMemorySize, LDS_BYTES);
        (void)hipOccupancyMaxActiveBlocksPerMultiprocessor(&per_cu, (const void*)fwd<true>, 512, LDS_BYTES);
        if (per_cu < 1) { fprintf(stderr, "kernel_launch: occupancy query says %d blocks per CU\n", per_cu); per_cu = 1; }
        (void)hipGetLastError();
        grid = cus;
    }
    if (grid < 0) return;
    (void)hipMemsetAsync((char*)d_ws + WS_CTL, 0, CTL_BYTES, stream);
    Args a{};
    for (int i = 0; i < 21; ++i) a.in.p[i] = (const float*)d_in[i];
    a.out = (float*)d_out; a.ws = (unsigned char*)d_ws;
#if MK_ONE_LAUNCH
    a.ph_lo = 0; a.ph_hi = NPHASE;
    void* args[] = {&a};
    hipError_t e = hipLaunchCooperativeKernel((const void*)fwd<true>, dim3(grid), dim3(512), args, LDS_BYTES, stream);
    if (e != hipSuccess) fprintf(stderr, "cooperative launch failed: %s (grid %d)\n", hipGetErrorString(e), grid);
#else
    for (int ph = 0; ph < NPHASE; ++ph) { a.ph_lo = ph; a.ph_hi = ph + 1; hipLaunchKernelGGL(fwd<false>, dim3(grid), dim3(512), LDS_BYTES, stream, a); }
#endif
}
```

```cpp
#include <hip/hip_runtime.h>
#include <hip/hip_cooperative_groups.h>
#include <cstdio>
#include <cstdint>
#include <cmath>
namespace cg = cooperative_groups;

#define LAS __attribute__((address_space(3)))
#define GAS __attribute__((address_space(1)))
typedef unsigned short bf16_t;
typedef short bf16x8 __attribute__((ext_vector_type(8)));
typedef short s16x4 __attribute__((ext_vector_type(4)));
typedef float f32x2 __attribute__((ext_vector_type(2)));
typedef float f32x4 __attribute__((ext_vector_type(4)));
typedef float f32x16 __attribute__((ext_vector_type(16)));
typedef unsigned u32x2 __attribute__((ext_vector_type(2)));
typedef unsigned u32x4 __attribute__((ext_vector_type(4)));

constexpr int DM = 1024, NB = 16, SEQ = 4096, NL = 2, SBAT = 32, SSEQ = 16, PAST = 512;
constexpr int MP = NB * SEQ, MS = SBAT * SSEQ, MT = MP + MS;
constexpr int DS = 512, NG = 32, NP = 64, NCHN = 16, NH = 8, HD = 64, DIN = 3072, NREL = 257;
constexpr int NCH = SEQ / 64;
constexpr float EPS = 1e-6f;
constexpr float LOG2E = 1.4426950408889634f;
constexpr float QSCALE = 0.125f * LOG2E;

constexpr size_t O_YP = 0, O_YS = 67108864, O_KP = 67633152, O_VP = 76021760, O_RP = 84410368, O_IP = 84475904,
                 O_KS = 84541440, O_VS = 85065728, O_RS = 85590016, O_IS = 85721088, O_END = 85852160;

constexpr size_t MiB = 1u << 20;
constexpr size_t WS_CTL = 0, CTL_BYTES = 1 * MiB;
constexpr size_t WS_WIN = 1 * MiB, WIN_L = 6 * MiB;
constexpr size_t WS_WGLU = 13 * MiB, WGLU_L = 1 * MiB;
constexpr size_t WS_WOUT = 15 * MiB, WOUT_L = 2 * MiB;
constexpr size_t WS_TAB = 19 * MiB, TAB_L = 2 * MiB;
constexpr size_t WS_PM = 24 * MiB, PM_L = 16 * MiB;
constexpr size_t WS_ROWSS = 56 * MiB;
constexpr size_t WS_HIN = 61 * MiB;
constexpr size_t WS_XB = 77 * MiB;
constexpr size_t ACT_STRIDE = 65 * MiB;
constexpr size_t WS_U = 206 * MiB, WS_SG = WS_U + ACT_STRIDE, WS_Q = WS_SG + ACT_STRIDE, WS_K = WS_Q + ACT_STRIDE, WS_V = WS_K + ACT_STRIDE,
                 WS_SGA = WS_V + ACT_STRIDE, WS_YG = WS_SGA + ACT_STRIDE, WS_MIX = WS_YG + ACT_STRIDE, WS_END = WS_MIX + 129 * MiB;
static_assert(WS_END <= 1024 * MiB, "workspace");
constexpr size_t T_AB = 0, T_A64 = 16384, T_BU = 32768, T_D = T_BU + 262144, T_C = T_D + 32768, T_BIAS = T_C + 131072, T_END = T_BIAS + 524288;
static_assert(T_END <= TAB_L, "tables");
constexpr int CW_QUEUE = 1024;
constexpr int CW_BAR = 8192;

__device__ __forceinline__ unsigned f2bf(float f) { unsigned u = __builtin_bit_cast(unsigned, f); return (u + 0x7fffu + ((u >> 16) & 1u)) >> 16; }
__device__ __forceinline__ float bf2f(unsigned h) { return __builtin_bit_cast(float, h << 16); }
typedef __bf16 bf16x2_t __attribute__((ext_vector_type(2)));
__device__ __forceinline__ unsigned pk2(float lo, float hi) { const f32x2 v = {lo, hi}; const bf16x2_t b = __builtin_convertvector(v, bf16x2_t); return __builtin_bit_cast(unsigned, b); }
__device__ __forceinline__ float silu_f(float x) { return x / (1.0f + __expf(-x)); }
__device__ __forceinline__ float sigmoid_f(float x) { return 1.0f / (1.0f + __expf(-x)); }
__device__ __forceinline__ float gelu_tanh(float x) { const float u = 0.7978845608028654f * (x + 0.044715f * x * x * x); const float e = __expf(2.0f * u); const float t = 1.0f - 2.0f / (e + 1.0f); return 0.5f * x * (1.0f + t); }
namespace pg8 {
#define PG8_LAS __attribute__((address_space(3)))
constexpr int BM = 256, BK = 64, HALF = 128, HTB = HALF * BK * 2  , STAGE_BYTES = 8 * HTB, NXCD = 8, WGM = 8;

__host__ __device__ __forceinline__ int lds_byte(int r, int c) { const int st = (r >> 4) * 2 + (c >> 5), rr = r & 15, cc = c & 31, ob = rr * 64 + cc * 2; return st * 1024 + (ob ^ (((ob >> 9) & 1) << 5)); }
__host__ __device__ __forceinline__ void stage_rc(int b, int& R, int& C) { const int st = b / 1024, sb = b % 1024, swz = sb ^ (((sb >> 9) & 1) << 5); R = (st >> 1) * 16 + swz / 64; C = (st & 1) * 32 + (swz % 64) / 2; }
__host__ __device__ __forceinline__ int perm32(int rho) { const int n = rho >> 4, i = rho & 15; return 8 * (i >> 2) + 4 * n + (i & 3); }

struct Unit { int pm, pn; };

struct GemmStd {
    const char* A; const char* Bt; int K;
    __device__ __forceinline__ const char* a_base(const Unit& u) const { return A + (size_t)u.pm * BM * K * 2; }
    __device__ __forceinline__ const char* b_base(const Unit& u) const { return Bt + (size_t)u.pn * BM * K * 2; }
    __device__ __forceinline__ unsigned a_voff(int R, int C) const { return (unsigned)(R * K + C) * 2u; }
    __device__ __forceinline__ unsigned b_voff(int R, int C) const { return (unsigned)(R * K + C) * 2u; }
    __device__ __forceinline__ size_t a_kstep() const { return BK * 2; }
    __device__ __forceinline__ size_t b_kstep() const { return BK * 2; }
    __device__ __forceinline__ size_t a_hstep() const { return (size_t)HALF * K * 2; }
    __device__ __forceinline__ size_t b_hstep() const { return (size_t)HALF * K * 2; }
    __device__ __forceinline__ int nt() const { return K / BK; }
};
struct GemmPassA {
    const char* U; const char* PM;
    __device__ __forceinline__ const char* a_base(const Unit& u) const { return U + (size_t)(u.pm >> 2) * 32 + (size_t)(u.pm & 3) * 256 * 65536; }
    __device__ __forceinline__ const char* b_base(const Unit& u) const { return PM + (size_t)(u.pm >> 2) * (256 * 1024 * 2); }
    __device__ __forceinline__ unsigned a_voff(int R, int C) const { return (unsigned)R * 65536u + (unsigned)(C >> 4) * 1024u + (unsigned)(C & 15) * 2u; }
    __device__ __forceinline__ unsigned b_voff(int R, int C) const { return (unsigned)(R * 1024 + C) * 2u; }
    __device__ __forceinline__ size_t a_kstep() const { return 4096; }
    __device__ __forceinline__ size_t b_kstep() const { return BK * 2; }
    __device__ __forceinline__ size_t a_hstep() const { return (size_t)HALF * 65536; }
    __device__ __forceinline__ size_t b_hstep() const { return (size_t)HALF * 1024 * 2; }
    __device__ __forceinline__ int nt() const { return 16; }
};

struct StaticOrder {
    int nM, nN, nwg, G, c;
    __host__ __device__ void init(int M, int N, int G_, int c_) { nM = M / BM; nN = N / BM; nwg = nM * nN; G = G_; c = c_; }
    __host__ __device__ bool next(int i, Unit& u) const {
        const long L = (long)i * G + c; if (L >= nwg) return false;
        int wgid = (int)L; { const int q = nwg / NXCD, r = nwg % NXCD, xcd = wgid % NXCD, off = wgid / NXCD; wgid = (xcd < r ? xcd * (q + 1) : r * (q + 1) + (xcd - r) * q) + off; }
        const int nig = WGM * nN, gid = wgid / nig, fm = gid * WGM, gsz = (nM - fm) < WGM ? (nM - fm) : WGM;
        u.pm = fm + ((wgid % nig) % gsz); u.pn = (wgid % nig) / gsz; return true;
    }
    __device__ __forceinline__ void a_ready(const Unit&) const {}
    __device__ __forceinline__ void done(const Unit&) const {}
};
struct OneUnitOrder {
    int n, c;
    __device__ __forceinline__ bool next(int i, Unit& u) const { if (i != 0 || c >= n) return false; u.pm = c; u.pn = 0; return true; }
    __device__ __forceinline__ void a_ready(const Unit&) const {}
    __device__ __forceinline__ void done(const Unit&) const {}
};


struct EpiInProj {
    static constexpr bool PERM = false, AFTER_DRAIN = false, HAS_INIT = false;
    const float* rowss; unsigned char* ws; const float* qg; const float* kg; float* out; int layer;
    __device__ __forceinline__ void operator()(const f32x4 (&acc)[2][2][4][2], const Unit& u, int wr, int wc, int fr, int fq) const {
        const int kind = u.pn >> 1;
        bf16_t* dst = (bf16_t*)(ws + WS_U + (size_t)kind * ACT_STRIDE);
        const int colb = (u.pn & 1) * 256 + wc * 64 + fq * 16;
        float gv[16];
#pragma unroll
        for (int e = 0; e < 16; ++e) gv[e] = 1.f;
        if (kind == 2 || kind == 3) { const float* gp = (kind == 2 ? qg : kg) + fq * 16;
#pragma unroll
            for (int e4 = 0; e4 < 4; ++e4) { const f32x4 t = *(const GAS f32x4*)(gp + 4 * e4); gv[4 * e4] = t.x; gv[4 * e4 + 1] = t.y; gv[4 * e4 + 2] = t.z; gv[4 * e4 + 3] = t.w; }
            if (kind == 2) {
#pragma unroll
                for (int e = 0; e < 16; ++e) gv[e] *= QSCALE; } }
        const bool want_out = (kind == 3 || kind == 4) && (u.pm >= 256 || (u.pm & 15) >= 14);
        float* ob = out + (kind == 3 ? (u.pm >= 256 ? O_KS : O_KP) : (u.pm >= 256 ? O_VS : O_VP));
#pragma unroll
        for (int ai = 0; ai < 2; ++ai)
#pragma unroll
            for (int m = 0; m < 4; ++m) {
                const int row = u.pm * BM + ai * HALF + wr * 64 + m * 16 + fr;
                const f32x4 pr = *(const GAS f32x4*)(rowss + (size_t)row * 16 + fq * 4);
                float ss = (pr.x + pr.y) + (pr.z + pr.w); ss += __shfl_xor(ss, 16); ss += __shfl_xor(ss, 32);
                const float rstd = rsqrtf(ss * (1.0f / 1024.0f) + EPS);
                float v[16];
#pragma unroll
                for (int bj = 0; bj < 2; ++bj)
#pragma unroll
                    for (int n = 0; n < 2; ++n)
#pragma unroll
                        for (int i = 0; i < 4; ++i) v[8 * bj + 4 * n + i] = acc[ai][bj][m][n][i] * rstd;
                if (kind == 1 || kind == 5) {
#pragma unroll
                    for (int e = 0; e < 16; ++e) v[e] = silu_f(v[e]);
                } else if (kind == 2 || kind == 3) {
                    float q = 0.f;
#pragma unroll
                    for (int e = 0; e < 16; ++e) q += v[e] * v[e];
                    q += __shfl_xor(q, 16); q += __shfl_xor(q, 32);
                    const float r = rsqrtf(q * (1.0f / 64.0f) + EPS);
#pragma unroll
                    for (int e = 0; e < 16; ++e) v[e] = v[e] * r * gv[e];
                }
                u32x4 w0, w1;
                w0.x = pk2(v[0], v[1]); w0.y = pk2(v[2], v[3]); w0.z = pk2(v[4], v[5]); w0.w = pk2(v[6], v[7]);
                w1.x = pk2(v[8], v[9]); w1.y = pk2(v[10], v[11]); w1.z = pk2(v[12], v[13]); w1.w = pk2(v[14], v[15]);
                bf16_t* dp = dst + (size_t)row * 512 + colb;
                *(GAS u32x4*)dp = w0; *(GAS u32x4*)(dp + 8) = w1;
                if (want_out) {
                    long orow = -1;
                    if (row >= MP) orow = (long)layer * MS + (row - MP);
                    else { const int t = row & (SEQ - 1); if (t >= SEQ - PAST) orow = ((long)layer * NB + (row >> 12)) * PAST + (t - (SEQ - PAST)); }
                    if (orow >= 0) { float* op = ob + orow * 512 + colb;
                        float vo[16];
#pragma unroll
                        for (int e = 0; e < 16; ++e) vo[e] = (kind == 3) ? v[e] : v[e];
#pragma unroll
                        for (int e4 = 0; e4 < 4; ++e4) *(GAS f32x4*)(op + 4 * e4) = (f32x4){vo[4 * e4], vo[4 * e4 + 1], vo[4 * e4 + 2], vo[4 * e4 + 3]}; }
                }
            }
    }
};

struct EpiGlu {
    static constexpr bool PERM = false, AFTER_DRAIN = false, HAS_INIT = false;
    const bf16_t* SG; bf16_t* MIX;
    __device__ __forceinline__ void operator()(const f32x4 (&acc)[2][2][4][2], const Unit& u, int wr, int wc, int fr, int fq) const {
        const int col = u.pn * 128 + wc * 32 + fq * 8;
#pragma unroll
        for (int ai = 0; ai < 2; ++ai)
#pragma unroll
            for (int m = 0; m < 4; ++m) {
                const int row = u.pm * BM + ai * HALF + wr * 64 + m * 16 + fr;
                const u32x4 sg = *(const GAS u32x4*)(SG + (size_t)row * 512 + col);
                float o[8];
#pragma unroll
                for (int n = 0; n < 2; ++n)
#pragma unroll
                    for (int i = 0; i < 4; ++i) { const int e = 4 * n + i; const unsigned sw = sg[e >> 1]; const float s = bf2f((e & 1) ? (sw >> 16) : (sw & 0xffffu));
                        o[e] = acc[ai][0][m][n][i] * sigmoid_f(acc[ai][1][m][n][i]) * s; }
                u32x4 w; w.x = pk2(o[0], o[1]); w.y = pk2(o[2], o[3]); w.z = pk2(o[4], o[5]); w.w = pk2(o[6], o[7]);
                *(GAS u32x4*)(MIX + (size_t)row * 1024 + col) = w;
            }
    }
};

struct EpiOut {
    static constexpr bool PERM = false, AFTER_DRAIN = false, HAS_INIT = true;
    const float* resP; const float* resS; float* outP; float* outS; bf16_t* XB; float* rowss; int first;
    __device__ __forceinline__ void init(f32x4 (&acc)[2][2][4][2], const Unit& u, int wr, int wc, int fr, int fq) const {
        const int col = u.pn * 256 + wc * 64 + fq * 16;
#pragma unroll
        for (int ai = 0; ai < 2; ++ai)
#pragma unroll
            for (int m = 0; m < 4; ++m) {
                const int row = u.pm * BM + ai * HALF + wr * 64 + m * 16 + fr;
                if (first) { const float* rp = (row < MP) ? resP + (size_t)row * DM + col : resS + (size_t)(row - MP) * DM + col;
#pragma unroll
                    for (int bj = 0; bj < 2; ++bj)
#pragma unroll
                        for (int n = 0; n < 2; ++n) acc[ai][bj][m][n] = *(const GAS f32x4*)(rp + 8 * bj + 4 * n);
                } else { const bf16_t* xp = XB + (size_t)row * DM + col;
#pragma unroll
                    for (int bj = 0; bj < 2; ++bj) { const u32x4 w = *(const GAS u32x4*)(xp + 8 * bj);
                        acc[ai][bj][m][0] = (f32x4){bf2f(w.x & 0xffffu), bf2f(w.x >> 16), bf2f(w.y & 0xffffu), bf2f(w.y >> 16)};
                        acc[ai][bj][m][1] = (f32x4){bf2f(w.z & 0xffffu), bf2f(w.z >> 16), bf2f(w.w & 0xffffu), bf2f(w.w >> 16)}; }
                }
            }
    }
    __device__ __forceinline__ void operator()(const f32x4 (&acc)[2][2][4][2], const Unit& u, int wr, int wc, int fr, int fq) const {
        const int col = u.pn * 256 + wc * 64 + fq * 16;
#pragma unroll
        for (int ai = 0; ai < 2; ++ai)
#pragma unroll
            for (int m = 0; m < 4; ++m) {
                const int row = u.pm * BM + ai * HALF + wr * 64 + m * 16 + fr;
                if (first) {
                    float ss = 0.f;
#pragma unroll
                    for (int bj = 0; bj < 2; ++bj)
#pragma unroll
                        for (int n = 0; n < 2; ++n) { const f32x4 t = acc[ai][bj][m][n]; ss += (t.x * t.x + t.y * t.y) + (t.z * t.z + t.w * t.w); }
                    ss += __shfl_xor(ss, 16); ss += __shfl_xor(ss, 32);
                    u32x4 w0, w1;
                    w0.x = pk2(acc[ai][0][m][0].x, acc[ai][0][m][0].y); w0.y = pk2(acc[ai][0][m][0].z, acc[ai][0][m][0].w); w0.z = pk2(acc[ai][0][m][1].x, acc[ai][0][m][1].y); w0.w = pk2(acc[ai][0][m][1].z, acc[ai][0][m][1].w);
                    w1.x = pk2(acc[ai][1][m][0].x, acc[ai][1][m][0].y); w1.y = pk2(acc[ai][1][m][0].z, acc[ai][1][m][0].w); w1.z = pk2(acc[ai][1][m][1].x, acc[ai][1][m][1].y); w1.w = pk2(acc[ai][1][m][1].z, acc[ai][1][m][1].w);
                    bf16_t* xp = XB + (size_t)row * DM + col;
                    *(GAS u32x4*)xp = w0; *(GAS u32x4*)(xp + 8) = w1;
                    if (fq == 0) *(GAS float*)(rowss + (size_t)row * 16 + u.pn * 4 + wc) = ss;
                } else {
                    float* op = (row < MP) ? outP + (size_t)row * DM + col : outS + (size_t)(row - MP) * DM + col;
#pragma unroll
                    for (int bj = 0; bj < 2; ++bj)
#pragma unroll
                        for (int n = 0; n < 2; ++n) *(GAS f32x4*)(op + 8 * bj + 4 * n) = acc[ai][bj][m][n];
                }
            }
    }
};

struct EpiPassA {
    static constexpr bool PERM = false, AFTER_DRAIN = true, HAS_INIT = false;
    const f32x2* a64; f32x2* hin; float* out; int layer;
    __device__ __forceinline__ void fused(const f32x4 (&acc)[2][2][4][2], const Unit& u, int wr, int wc, int fr, int fq, PG8_LAS unsigned char* lds, int wid, int lane) const {
        PG8_LAS float* S = (PG8_LAS float*)lds;
#pragma unroll
        for (int ai = 0; ai < 2; ++ai)
#pragma unroll
            for (int m = 0; m < 4; ++m) { const int r = ai * HALF + wr * 64 + m * 16 + fr;
#pragma unroll
                for (int n = 0; n < 2; ++n) *(PG8_LAS f32x4*)(S + r * 128 + wc * 32 + n * 16 + fq * 4) = acc[ai][0][m][n] + acc[ai][1][m][n]; }
        asm volatile("s_waitcnt lgkmcnt(0)" ::: "memory"); __builtin_amdgcn_s_barrier(); asm volatile("" ::: "memory");
        const int tid = wid * 64 + lane;
        if (tid < 256) {
            const int bl = tid >> 6, p = tid & 63, g = u.pm >> 2, b = (u.pm & 3) * 4 + bl;
            const f32x2 a = *(const GAS f32x2*)(a64 + g * 64 + p);
            float hr = 0.f, hi = 0.f;
            f32x2* hp = hin + ((size_t)(b * NCH) * NG + g) * NP + p;
            for (int c = 0; c < NCH; ++c) {
                const f32x2 s = *(const PG8_LAS f32x2*)(S + (bl * 64 + c) * 128 + 2 * p);
                *(GAS f32x2*)(hp + (size_t)c * NG * NP) = (f32x2){hr, hi};
                const float nr = a.x * hr - a.y * hi + s.x, ni = a.x * hi + a.y * hr + s.y;
                hr = nr; hi = ni;
            }
            const size_t o = ((size_t)(layer * NB + b) * NG + g) * NP + p;
            *(GAS float*)(out + O_RP + o) = hr; *(GAS float*)(out + O_IP + o) = hi;
        }
        asm volatile("s_waitcnt lgkmcnt(0)" ::: "memory"); __builtin_amdgcn_s_barrier(); asm volatile("" ::: "memory");
    }
};

template <class Epi, class Sched, class GP, bool ALIGN_EPI = false, bool SP2 = false>
__device__ __forceinline__ void gemm_phase(PG8_LAS unsigned char* lds, const GP& g, const Sched& S, const Epi& E) {
    int tid_ = threadIdx.x; asm volatile("" : "+v"(tid_));
    const int tid = tid_, wid = __builtin_amdgcn_readfirstlane(tid >> 6), lane = tid & 63, wr = wid >> 2, wc = wid & 3, fr = lane & 15, fq = lane >> 4;
    const int nt = g.nt();
    unsigned voffA[2], voffB[2];
#pragma unroll
    for (int i = 0; i < 2; ++i) { int R, C; stage_rc(tid * 16 + i * 8192, R, C); const int Rb = Epi::PERM ? ((R & ~31) + perm32(R & 31)) : R;
        voffA[i] = g.a_voff(R, C); voffB[i] = g.b_voff(Rb, C); }
    const size_t kstepA = g.a_kstep(), kstepB = g.b_kstep(), hstepA = g.a_hstep(), hstepB = g.b_hstep();
    const unsigned ldsw = (unsigned)wid * 1024u;
    const int aoff = lds_byte(wr * 64 + fr, fq * 8), boff = lds_byte(wc * 32 + fr, fq * 8);
#define PG8_SA(b, h) (((b) * 2 + (h)) * HTB)
#define PG8_SB(b, h) ((4 + (b) * 2 + (h)) * HTB)
#define PG8_STAGE(bufoff, gbase, voff) do { _Pragma("unroll") for (int _i = 0; _i < 2; ++_i) \
        __builtin_amdgcn_global_load_lds((const unsigned*)((const char*)(gbase) + (voff)[_i]), (PG8_LAS unsigned*)(lds + (bufoff) + ldsw + _i * 8192), 16, 0, 0); } while (0)
#define PG8_LDA(dst, b, h) do { _Pragma("unroll") for (int m = 0; m < 4; ++m) _Pragma("unroll") for (int k = 0; k < 2; ++k) dst[m][k] = *(const PG8_LAS bf16x8*)(lds + PG8_SA(b, h) + aoff + m * 2048 + k * 1024); } while (0)
#define PG8_LDB(dst, b, h) do { _Pragma("unroll") for (int n = 0; n < 2; ++n) _Pragma("unroll") for (int k = 0; k < 2; ++k) dst[n][k] = *(const PG8_LAS bf16x8*)(lds + PG8_SB(b, h) + boff + n * 2048 + k * 1024); } while (0)
#define PG8_MMA(ai, bj, At, Bt) do { __builtin_amdgcn_s_setprio(1); _Pragma("unroll") for (int m = 0; m < 4; ++m) _Pragma("unroll") for (int n = 0; n < 2; ++n) _Pragma("unroll") for (int k = 0; k < 2; ++k) \
        acc[ai][bj][m][n] = __builtin_amdgcn_mfma_f32_16x16x32_bf16(Bt[n][k], At[m][k], acc[ai][bj][m][n], 0, 0, 0); __builtin_amdgcn_s_setprio(0); } while (0)
#define PG8_WAIT_V(n) asm volatile("s_waitcnt vmcnt(" #n ")" ::: "memory")
#define PG8_WAIT_L(n) asm volatile("s_waitcnt lgkmcnt(" #n ")" ::: "memory")
#define PG8_BAR __builtin_amdgcn_s_barrier()
#define PG8_SCHED __builtin_amdgcn_sched_barrier(0)
    Unit cur, nxt; int ui = 0;
    if (!S.next(0, cur)) return;
    f32x4 acc[2][2][4][2];
    if constexpr (Epi::HAS_INIT) E.init(acc, cur, wr, wc, fr, fq);
    else {
#pragma unroll
    for (int a = 0; a < 2; ++a)
#pragma unroll
        for (int b = 0; b < 2; ++b)
#pragma unroll
            for (int m = 0; m < 4; ++m)
#pragma unroll
                for (int n = 0; n < 2; ++n) acc[a][b][m][n] = (f32x4){0.f, 0.f, 0.f, 0.f};
    }
    bf16x8 At[4][2], B0[2][2], B1[2][2];
    const char* cA = g.a_base(cur); const char* cB = g.b_base(cur);
    S.a_ready(cur);
    if constexpr (SP2) {
        PG8_STAGE(PG8_SB(0, 0), cB, voffB); PG8_STAGE(PG8_SB(0, 1), cB + hstepB, voffB); PG8_STAGE(PG8_SA(0, 0), cA, voffA); PG8_STAGE(PG8_SA(0, 1), cA + hstepA, voffA);
        if (wr == 1) PG8_BAR;
        PG8_WAIT_V(2); PG8_BAR;
        PG8_STAGE(PG8_SB(1, 0), cB + kstepB, voffB); PG8_STAGE(PG8_SA(1, 0), cA + kstepA, voffA); PG8_STAGE(PG8_SB(1, 1), cB + hstepB + kstepB, voffB);
        PG8_WAIT_V(6); PG8_BAR;
    } else {
        PG8_STAGE(PG8_SB(0, 0), cB, voffB); PG8_STAGE(PG8_SA(0, 0), cA, voffA); PG8_STAGE(PG8_SB(0, 1), cB + hstepB, voffB); PG8_STAGE(PG8_SA(0, 1), cA + hstepA, voffA);
        if (wr == 1) PG8_BAR;
        PG8_WAIT_V(4); PG8_BAR;
        PG8_STAGE(PG8_SB(1, 0), cB + kstepB, voffB); PG8_STAGE(PG8_SA(1, 0), cA + kstepA, voffA); PG8_STAGE(PG8_SB(1, 1), cB + hstepB + kstepB, voffB);
        PG8_WAIT_V(6); PG8_BAR;
    }
    for (;;) {
        const bool has_next = S.next(ui + 1, nxt);
        const char* nA = has_next ? g.a_base(nxt) : cA; const char* nB = has_next ? g.b_base(nxt) : cB;
        for (int t = 0; t < nt; t += 2) {
            const bool last = (t == nt - 2);
            const char* a1 = cA + (size_t)(t + 1) * kstepA;
            const char* a2 = last ? nA : cA + (size_t)(t + 2) * kstepA; const char* b2 = last ? nB : cB + (size_t)(t + 2) * kstepB;
            const char* a3 = a2 + kstepA; const char* b3 = b2 + kstepB;
            if (last && has_next) S.a_ready(nxt);
            if constexpr (SP2) {
            PG8_LDB(B0, 0, 0); PG8_LDB(B1, 0, 1); PG8_SCHED; PG8_LDA(At, 0, 0); PG8_STAGE(PG8_SA(1, 1), a1 + hstepA, voffA);
            PG8_WAIT_V(8); PG8_WAIT_L(0); PG8_BAR; PG8_MMA(0, 0, At, B0); PG8_MMA(0, 1, At, B1); PG8_BAR; PG8_SCHED;
            PG8_LDA(At, 0, 1); PG8_STAGE(PG8_SB(0, 0), b2, voffB); PG8_STAGE(PG8_SB(0, 1), b2 + hstepB, voffB); PG8_STAGE(PG8_SA(0, 0), a2, voffA);
            PG8_WAIT_V(8); PG8_WAIT_L(0); PG8_BAR; PG8_MMA(1, 0, At, B0); PG8_MMA(1, 1, At, B1); PG8_BAR; PG8_SCHED;
            PG8_LDB(B0, 1, 0); PG8_LDB(B1, 1, 1); PG8_SCHED; PG8_LDA(At, 1, 0); PG8_STAGE(PG8_SA(0, 1), a2 + hstepA, voffA);
            PG8_WAIT_V(8); PG8_WAIT_L(0); PG8_BAR; PG8_MMA(0, 0, At, B0); PG8_MMA(0, 1, At, B1); PG8_BAR; PG8_SCHED;
            PG8_LDA(At, 1, 1); PG8_STAGE(PG8_SB(1, 0), b3, voffB); PG8_STAGE(PG8_SB(1, 1), b3 + hstepB, voffB); PG8_STAGE(PG8_SA(1, 0), a3, voffA);
            PG8_WAIT_V(8); PG8_WAIT_L(0); PG8_BAR; PG8_MMA(1, 0, At, B0); PG8_MMA(1, 1, At, B1); PG8_BAR; PG8_SCHED;
            } else {
            PG8_LDB(B0, 0, 0); PG8_SCHED; PG8_LDA(At, 0, 0); PG8_STAGE(PG8_SA(1, 1), a1 + hstepA, voffA);
            PG8_WAIT_L(8); PG8_BAR; PG8_WAIT_L(0); PG8_MMA(0, 0, At, B0); PG8_BAR; PG8_SCHED;
            PG8_LDB(B1, 0, 1); PG8_STAGE(PG8_SB(0, 0), b2, voffB);
            PG8_BAR; PG8_WAIT_L(0); PG8_MMA(0, 1, At, B1); PG8_BAR;
            PG8_LDA(At, 0, 1); PG8_STAGE(PG8_SA(0, 0), a2, voffA);
            PG8_BAR; PG8_WAIT_L(0); PG8_MMA(1, 0, At, B0); PG8_BAR; PG8_SCHED;
            PG8_STAGE(PG8_SB(0, 1), b2 + hstepB, voffB);
            PG8_WAIT_V(6); PG8_BAR; PG8_MMA(1, 1, At, B1); PG8_BAR;
            PG8_LDB(B0, 1, 0); PG8_SCHED; PG8_LDA(At, 1, 0); PG8_STAGE(PG8_SA(0, 1), a2 + hstepA, voffA);
            PG8_WAIT_L(8); PG8_BAR; PG8_WAIT_L(0); PG8_MMA(0, 0, At, B0); PG8_BAR; PG8_SCHED;
            PG8_LDB(B1, 1, 1); PG8_STAGE(PG8_SB(1, 0), b3, voffB);
            PG8_BAR; PG8_WAIT_L(0); PG8_MMA(0, 1, At, B1); PG8_BAR;
            PG8_LDA(At, 1, 1); PG8_STAGE(PG8_SA(1, 0), a3, voffA);
            PG8_BAR; PG8_WAIT_L(0); PG8_MMA(1, 0, At, B0); PG8_BAR; PG8_SCHED;
            PG8_STAGE(PG8_SB(1, 1), b3 + hstepB, voffB);
            PG8_WAIT_V(6); PG8_BAR; PG8_MMA(1, 1, At, B1); PG8_BAR;
            }
        }
        if constexpr (ALIGN_EPI) { if (wr == 0) PG8_BAR; }
        if constexpr (!Epi::AFTER_DRAIN) { E(acc, cur, wr, wc, fr, fq); S.done(cur); }
        if (!has_next) break;
        if constexpr (Epi::HAS_INIT) E.init(acc, nxt, wr, wc, fr, fq);
        else {
#pragma unroll
        for (int a = 0; a < 2; ++a)
#pragma unroll
            for (int b = 0; b < 2; ++b)
#pragma unroll
                for (int m = 0; m < 4; ++m)
#pragma unroll
                    for (int n = 0; n < 2; ++n) acc[a][b][m][n] = (f32x4){0.f, 0.f, 0.f, 0.f};
        }
        cur = nxt; cA = nA; cB = nB; ++ui;
        if constexpr (ALIGN_EPI) { if (wr == 1) PG8_BAR; }
    }
    PG8_WAIT_V(0);
    if constexpr (!ALIGN_EPI) { if (wr == 0) PG8_BAR; }
    PG8_BAR;
    if constexpr (Epi::AFTER_DRAIN) { E.fused(acc, cur, wr, wc, fr, fq, lds, wid, lane); S.done(cur); }
#undef PG8_SA
#undef PG8_SB
#undef PG8_STAGE
#undef PG8_LDA
#undef PG8_LDB
#undef PG8_MMA
#undef PG8_WAIT_V
#undef PG8_WAIT_L
#undef PG8_BAR
#undef PG8_SCHED
}
}
struct InPtrs { const float* p[21]; };
typedef const float* fptr_t;
typedef __attribute__((address_space(4))) const fptr_t* kargp_t;
__device__ __forceinline__ int rowmap_inout(int col) {
    const int a = col & 255, wc = a >> 6, fq = (a >> 4) & 3, bj = (a >> 3) & 1, n = (a >> 2) & 1, i = a & 3;
    return (col & ~255) + bj * 128 + wc * 32 + n * 16 + fq * 4 + i;
}
__device__ __forceinline__ int rowmap_glu(int c) {
    const int bj = c >> 9, j = c & 511, pn = j >> 7, jj = j & 127, wc = jj >> 5, fq = (jj >> 3) & 3, n = (jj >> 2) & 1, i = jj & 3;
    return pn * 256 + bj * 128 + wc * 32 + n * 16 + fq * 4 + i;
}
__device__ __forceinline__ void p0_transpose_item(const float* W, int K, int N, bf16_t* WT, int glu, const float* gain, LAS float* scr, int item, int lane) {
    const int nblk = N / 32, kb = item / nblk, nb = item % nblk, k0 = 64 * kb, n0 = 32 * nb;
#pragma unroll 8
    for (int i = 0; i < 32; ++i) { const int kk = 2 * i + (lane >> 5); float w = W[(size_t)(k0 + kk) * N + n0 + (lane & 31)]; if (gain) w *= gain[k0 + kk]; scr[kk * 33 + (lane & 31)] = w; }
    asm volatile("s_waitcnt lgkmcnt(0)" ::: "memory");
    const int c = lane & 7;
#pragma unroll
    for (int j = 0; j < 4; ++j) { const int n = (lane >> 3) + 8 * j; const LAS float* s = scr + (8 * c) * 33 + n;
        u32x4 o; o.x = pk2(s[0 * 33], s[1 * 33]); o.y = pk2(s[2 * 33], s[3 * 33]); o.z = pk2(s[4 * 33], s[5 * 33]); o.w = pk2(s[6 * 33], s[7 * 33]);
        const int dr = glu ? rowmap_glu(n0 + n) : rowmap_inout(n0 + n);
        *(u32x4*)(WT + (size_t)dr * K + k0 + 8 * c) = o; }
    asm volatile("s_waitcnt lgkmcnt(0)" ::: "memory");
}
__device__ __forceinline__ float wave_sum(float v) {
#pragma unroll
    for (int o = 1; o < 64; o <<= 1) v += __shfl_xor(v, o);
    return v;
}
struct Disc { double abr, abi, fr, fi, dt, ar, ai; };
__device__ __forceinline__ Disc s5_disc(kargp_t in, int l, int g, int p) {
    Disc d; d.ar = (double)in[8][(l * NG + g) * NP + p]; d.ai = (double)in[9][(l * NG + g) * NP + p]; d.dt = exp((double)in[15][l * NG + g]);
    const double mag = exp(d.dt * d.ar); double s, c; sincos(d.dt * d.ai, &s, &c);
    d.abr = mag * c; d.abi = mag * s;
    const double den = d.ar * d.ar + d.ai * d.ai, nr = d.abr - 1.0;
    d.fr = (nr * d.ar + d.abi * d.ai) / den; d.fi = (d.abi * d.ar - nr * d.ai) / den;
    return d;
}
__device__ __forceinline__ int crow(int r, int hi) { return (r & 3) + 8 * (r >> 2) + 4 * hi; }

__device__ __forceinline__ void p0_prologue(unsigned char* ws, LAS unsigned char* lds, int vcu, int G, int tid) {
    const int lane = tid & 63, wave = tid >> 6;
    kargp_t in = (kargp_t)__builtin_amdgcn_kernarg_segment_ptr(); asm volatile("" : "+s"(in));
    LAS float* scr = (LAS float*)(lds + wave * 16384);
    const int gw = vcu * 8 + wave, NGW = G * 8;
    constexpr int I_IN = (DM / 64) * (DIN / 32), I_GLU = (DS / 64) * (2 * DS / 32), I_OUT = (DM / 64) * (DM / 32), I_L = I_IN + I_GLU + I_OUT;
    for (int it = gw; it < NL * I_L; it += NGW) {
        const int l = it / I_L; int r = it % I_L;
        if (r < I_IN) { p0_transpose_item(in[7] + (size_t)l * DM * DIN, DM, DIN, (bf16_t*)(ws + WS_WIN + l * WIN_L), 0, in[6] + l * DM, scr, r, lane); continue; } r -= I_IN;
        if (r < I_GLU) { p0_transpose_item(in[16] + (size_t)l * DS * 2 * DS, DS, 2 * DS, (bf16_t*)(ws + WS_WGLU + l * WGLU_L), 1, nullptr, scr, r, lane); continue; } r -= I_GLU;
        p0_transpose_item(in[20] + (size_t)l * DM * DM, DM, DM, (bf16_t*)(ws + WS_WOUT + l * WOUT_L), 0, nullptr, scr, r, lane);
    }
    asm volatile("" : "+s"(in), "+s"(ws));
    {
        bf16_t* XB = (bf16_t*)(ws + WS_XB); float* rowss = (float*)(ws + WS_ROWSS);
        for (int m = gw; m < MT; m += NGW) {
            const float* xr = (m < MP) ? in[0] + (size_t)m * DM : in[1] + (size_t)(m - MP) * DM;
            f32x4 v[4]; float s = 0.f;
#pragma unroll
            for (int j = 0; j < 4; ++j) { v[j] = *(const f32x4*)(xr + 4 * lane + 256 * j); s += (v[j].x * v[j].x + v[j].y * v[j].y) + (v[j].z * v[j].z + v[j].w * v[j].w); }
            s = wave_sum(s);
#pragma unroll
            for (int j = 0; j < 4; ++j) { u32x2 o; o.x = pk2(v[j].x, v[j].y); o.y = pk2(v[j].z, v[j].w); *(u32x2*)(XB + (size_t)m * DM + 4 * lane + 256 * j) = o; }
            if (lane < 16) rowss[(size_t)m * 16 + lane] = (lane == 0) ? s : 0.f;
        }
    }
    asm volatile("" : "+s"(in), "+s"(ws));
    const int gt = vcu * 512 + tid, NGT = G * 512;
    for (int it = gt; it < NL * NG * NP; it += NGT) {
        const int l = it / (NG * NP), g = (it / NP) % NG, p = it % NP;
        const Disc d = s5_disc(in, l, g, p);
        unsigned char* tb = ws + WS_TAB + l * TAB_L;
        ((f32x2*)(tb + T_AB))[g * NP + p] = (f32x2){(float)d.abr, (float)d.abi};
        const double m64 = exp(64.0 * d.dt * d.ar); double s, c; sincos(64.0 * d.dt * d.ai, &s, &c);
        ((f32x2*)(tb + T_A64))[g * NP + p] = (f32x2){(float)(m64 * c), (float)(m64 * s)};
    }
    asm volatile("" : "+s"(in), "+s"(ws));
    for (int it = gt; it < NL * NG * 8 * 64; it += NGT) {
        const int l = it / (NG * 512), g = (it / 512) % NG, cb = (it / 64) % 8, ln = it % 64;
        const int p = 16 * (cb >> 1) + (ln & 15), ri = cb & 1;
        const Disc d = s5_disc(in, l, g, p);
        unsigned short o[8];
#pragma unroll
        for (int j = 0; j < 8; ++j) { const int k = 8 * (ln >> 4) + j, h = k & 15;
            const double br = (double)in[10][((size_t)(l * NG + g) * NP + p) * NCHN + h], bi = (double)in[11][((size_t)(l * NG + g) * NP + p) * NCHN + h];
            const float val = (float)(ri ? (d.fr * bi + d.fi * br) : (d.fr * br - d.fi * bi));
            const unsigned hi = f2bf(val); const unsigned lo = f2bf(val - bf2f(hi));
            o[j] = (unsigned short)(k < 16 ? hi : lo); }
        u32x4 w; w.x = o[0] | (o[1] << 16); w.y = o[2] | (o[3] << 16); w.z = o[4] | (o[5] << 16); w.w = o[6] | (o[7] << 16);
        ((u32x4*)(ws + WS_TAB + l * TAB_L + T_BU))[(g * 8 + cb) * 64 + ln] = w;
    }
    asm volatile("" : "+s"(in), "+s"(ws));
    for (int it = gt; it < NL * NG * 5 * 64; it += NGT) {
        const int l = it / (NG * 320), g = (it / 320) % NG, kb = (it / 64) % 5, ln = it % 64, h = ln & 15;
        unsigned short o[8];
        if (kb == 4) { const float dv = in[14][(l * NG + g) * NCHN + h]; const unsigned hi = f2bf(dv), lo = f2bf(dv - bf2f(hi));
#pragma unroll
            for (int j = 0; j < 8; ++j) { const int k = 8 * (ln >> 4) + j; o[j] = (unsigned short)(((k & 15) == h) ? (k < 16 ? hi : lo) : 0u); }
            u32x4 w; w.x = o[0] | (o[1] << 16); w.y = o[2] | (o[3] << 16); w.z = o[4] | (o[5] << 16); w.w = o[6] | (o[7] << 16);
            ((u32x4*)(ws + WS_TAB + l * TAB_L + T_D))[g * 64 + ln] = w;
        } else {
#pragma unroll
            for (int j = 0; j < 8; ++j) { const int kk = 8 * (ln >> 4) + j, p = 16 * kb + (kk >> 1), ri = kk & 1;
                const size_t ci = ((size_t)(l * NG + g) * NCHN + h) * NP + p;
                const float val = ri ? -in[13][ci] : in[12][ci]; o[j] = (unsigned short)f2bf(val); }
            u32x4 w; w.x = o[0] | (o[1] << 16); w.y = o[2] | (o[3] << 16); w.z = o[4] | (o[5] << 16); w.w = o[6] | (o[7] << 16);
            ((u32x4*)(ws + WS_TAB + l * TAB_L + T_C))[(g * 4 + kb) * 64 + ln] = w;
        }
    }
    asm volatile("" : "+s"(in), "+s"(ws));
    for (int it = gt; it < NL * NG * NP * 64; it += NGT) {
        const int l = it / (NG * NP * 64), g = (it / (NP * 64)) % NG, p = (it / 64) % NP, s = it % 64;
        const Disc d = s5_disc(in, l, g, p);
        const double n = (double)(63 - s), mg = exp(n * d.dt * d.ar); double sn, cs; sincos(n * d.dt * d.ai, &sn, &cs);
        const double wr = mg * cs, wi = mg * sn;
        const double zr = wr * d.fr - wi * d.fi, zi = wr * d.fi + wi * d.fr;
        unsigned short orh[16], oih[16], orl[16], oil[16];
#pragma unroll
        for (int h = 0; h < 16; ++h) {
            const double br = (double)in[10][((size_t)(l * NG + g) * NP + p) * NCHN + h], bi = (double)in[11][((size_t)(l * NG + g) * NP + p) * NCHN + h];
            const float vr = (float)(zr * br - zi * bi), vi = (float)(zr * bi + zi * br);
            const unsigned hr = f2bf(vr), hi = f2bf(vi);
            orh[h] = (unsigned short)hr; oih[h] = (unsigned short)hi; orl[h] = (unsigned short)f2bf(vr - bf2f(hr)); oil[h] = (unsigned short)f2bf(vi - bf2f(hi));
        }
        bf16_t* pm = (bf16_t*)(ws + WS_PM + l * PM_L) + (size_t)g * 256 * 1024 + 16 * s;
#pragma unroll
        for (int q = 0; q < 2; ++q) {
            u32x4 a, b, c, e;
            a.x = orh[8*q] | (orh[8*q+1] << 16); a.y = orh[8*q+2] | (orh[8*q+3] << 16); a.z = orh[8*q+4] | (orh[8*q+5] << 16); a.w = orh[8*q+6] | (orh[8*q+7] << 16);
            b.x = oih[8*q] | (oih[8*q+1] << 16); b.y = oih[8*q+2] | (oih[8*q+3] << 16); b.z = oih[8*q+4] | (oih[8*q+5] << 16); b.w = oih[8*q+6] | (oih[8*q+7] << 16);
            c.x = orl[8*q] | (orl[8*q+1] << 16); c.y = orl[8*q+2] | (orl[8*q+3] << 16); c.z = orl[8*q+4] | (orl[8*q+5] << 16); c.w = orl[8*q+6] | (orl[8*q+7] << 16);
            e.x = oil[8*q] | (oil[8*q+1] << 16); e.y = oil[8*q+2] | (oil[8*q+3] << 16); e.z = oil[8*q+4] | (oil[8*q+5] << 16); e.w = oil[8*q+6] | (oil[8*q+7] << 16);
            *(u32x4*)(pm + (size_t)(2 * p) * 1024 + 8 * q) = a; *(u32x4*)(pm + (size_t)(2 * p + 1) * 1024 + 8 * q) = b;
            *(u32x4*)(pm + (size_t)(128 + 2 * p) * 1024 + 8 * q) = c; *(u32x4*)(pm + (size_t)(128 + 2 * p + 1) * 1024 + 8 * q) = e;
        }
    }
    asm volatile("" : "+s"(in), "+s"(ws));
    for (int it = gt; it < NL * NH * 256; it += NGT) {
        const int l = it / (NH * 256), h = (it / 256) % NH, i = it % 256;
        const float* tab = in[19] + (size_t)(l * NH + h) * NREL;
        int d = i - 63; d = d > 128 ? 128 : d;
        ((float*)(ws + WS_TAB + l * TAB_L + T_BIAS))[h * 256 + i] = (tab[d + 128] - tab[256]) * LOG2E;
    }
}
namespace att {
constexpr int BUFB = 65536, LV = 32768, LWS = 131072 + 4096, LEB = 131072 + 8192;
constexpr float THR = 8.0f;
__device__ __forceinline__ s16x4 vtr(const LAS unsigned char* p) { return __builtin_bit_cast(s16x4, __builtin_amdgcn_ds_read_tr16_b64_v4i16((LAS s16x4*)p)); }

struct Ctx { const GAS unsigned char* ws; const GAS float* cache_k; const GAS float* cache_v; int layer; };

__device__ __forceinline__ void unit(const Ctx& C, LAS unsigned char* lds, int type, int seq, int n, int hg, int tid, int mode = 0) {
    const int lane = tid & 63, wid = __builtin_amdgcn_readfirstlane(tid >> 6), r32 = lane & 31, hi = lane >> 5, hh = wid >> 1, qh = wid & 1, head = hg * 4 + hh;
    const GAS bf16_t* Q = (const GAS bf16_t*)(C.ws + WS_Q); const GAS bf16_t* K = (const GAS bf16_t*)(C.ws + WS_K); const GAS bf16_t* V = (const GAS bf16_t*)(C.ws + WS_V);
    const GAS bf16_t* SGA = (const GAS bf16_t*)(C.ws + WS_SGA); GAS bf16_t* MIX = (GAS bf16_t*)(C.ws + (mode ? WS_YG : WS_MIX));
    const long qrow0 = type == 0 ? (long)seq * SEQ + n * 64 + qh * 32 : (long)MP + seq * SSEQ;
    const bool wave_valid = (type == 0) || (qh == 0);
    const bool row_valid = (type == 0) || (qh == 0 && r32 < SSEQ);
    LAS float* wsf = (LAS float*)(lds + LWS) + wid * 64;
    LAS float* eb = (LAS float*)(lds + LEB) + hh * 256;
    const int jstart = (type == 0 && n < 8) ? 8 - n : 0;
    __syncthreads();
    if (qh == 0) { const f32x4 e = *(const GAS f32x4*)(C.ws + WS_TAB + (size_t)C.layer * TAB_L + T_BIAS + ((size_t)head * 256 + lane * 4) * 4); *(LAS f32x4*)(eb + lane * 4) = e; }
    bf16x8 qr[4];
#pragma unroll
    for (int d0 = 0; d0 < 4; ++d0) { qr[d0] = (bf16x8){0, 0, 0, 0, 0, 0, 0, 0}; if (row_valid) qr[d0] = *(const GAS bf16x8*)(Q + (qrow0 + r32) * 512 + head * 64 + d0 * 16 + hi * 8); }
    const long krow_base = (long)seq * SEQ + (long)(n - 8) * 64;
    const int koff = (8 * wid + (lane >> 3)) * 512 + hg * 256 + (((lane & 7) ^ ((lane >> 3) & 7)) * 8);
    const int voff = (16 * (wid & 3) + (lane >> 2)) * 512 + hg * 256 + (wid >> 2) * 32 + (lane & 3) * 8;
#define ATT_DMA(jj, buf) do { const GAS bf16_t* kp_ = K + (krow_base + (long)(jj) * 64) * 512 + koff; const GAS bf16_t* vp_ = V + (krow_base + (long)(jj) * 64) * 512 + voff; \
        _Pragma("unroll") for (int i_ = 0; i_ < 4; ++i_) { \
            __builtin_amdgcn_global_load_lds((const GAS unsigned*)(kp_ + i_ * 64), (LAS unsigned*)(lds + (buf) * BUFB + (wid + 8 * i_) * 1024), 16, 0, 0); \
            __builtin_amdgcn_global_load_lds((const GAS unsigned*)(vp_ + i_ * 64), (LAS unsigned*)(lds + (buf) * BUFB + LV + (wid + 8 * i_) * 1024), 16, 0, 0); } } while (0)
    if (type == 0 && !(mode & 1)) ATT_DMA(jstart, 0);
    float m_run = 0.f, l_run = 0.f; bool first = true; f32x16 o[2]; o[0] = f32x16{}; o[1] = f32x16{};
    int cur = 0;
    for (int j = jstart; j < 9; ++j, cur ^= 1) {
        if (type == 1) {
            LAS unsigned char* kb_ = lds + cur * BUFB; LAS unsigned char* vb_ = kb_ + LV;
            if (j == 8) {
                const long krow0 = (long)MP + seq * SSEQ;
#pragma unroll 1
                for (int i = 0; i < 4; ++i) {
                    const int idx = tid + 512 * i;
                    { const int row = idx & 63, ch = (idx >> 6) & 7, h4 = idx >> 9; u32x4 v = (u32x4){0u, 0u, 0u, 0u};
                      if (row < SSEQ) v = *(const GAS u32x4*)(K + (krow0 + row) * 512 + (hg * 4 + h4) * 64 + ch * 8);
                      *(LAS u32x4*)(kb_ + h4 * 8192 + row * 128 + ((ch ^ (row & 7)) * 16)) = v; }
                    { const int h4 = idx >> 9, e = idx & 511, w8 = e >> 6, ln = e & 63, row = 16 * (w8 & 3) + (ln >> 2), dh = w8 >> 2, c16 = ln & 3; u32x4 v = (u32x4){0u, 0u, 0u, 0u};
                      if (row < SSEQ) v = *(const GAS u32x4*)(V + (krow0 + row) * 512 + (hg * 4 + h4) * 64 + dh * 32 + c16 * 8);
                      *(LAS u32x4*)(vb_ + idx * 16) = v; }
                }
            } else {
                const GAS float* ck = C.cache_k + ((size_t)(C.layer * SBAT + seq) * PAST + 64 * j) * (NH * HD);
                const GAS float* cv = C.cache_v + ((size_t)(C.layer * SBAT + seq) * PAST + 64 * j) * (NH * HD);
#pragma unroll 1
                for (int i = 0; i < 4; ++i) {
                    const int idx = tid + 512 * i;
                    { const int row = idx & 63, ch = (idx >> 6) & 7, h4 = idx >> 9; const GAS float* p = ck + (size_t)row * (NH * HD) + (hg * 4 + h4) * 64 + ch * 8;
                      const f32x4 a = *(const GAS f32x4*)p, b = *(const GAS f32x4*)(p + 4);
                      *(LAS u32x4*)(kb_ + h4 * 8192 + row * 128 + ((ch ^ (row & 7)) * 16)) = (u32x4){pk2(a.x, a.y), pk2(a.z, a.w), pk2(b.x, b.y), pk2(b.z, b.w)}; }
                    { const int h4 = idx >> 9, e = idx & 511, w8 = e >> 6, ln = e & 63, row = 16 * (w8 & 3) + (ln >> 2), dh = w8 >> 2, c16 = ln & 3;
                      const GAS float* p = cv + (size_t)row * (NH * HD) + (hg * 4 + h4) * 64 + dh * 32 + c16 * 8;
                      const f32x4 a = *(const GAS f32x4*)p, b = *(const GAS f32x4*)(p + 4);
                      *(LAS u32x4*)(vb_ + idx * 16) = (u32x4){pk2(a.x, a.y), pk2(a.z, a.w), pk2(b.x, b.y), pk2(b.z, b.w)}; }
                }
            }
        }
        __syncthreads();
        if (type == 0 && j < 8 && !(mode & 1)) ATT_DMA(j + 1, cur ^ 1);
        if (!wave_valid || (mode & 4)) continue;
        const LAS unsigned char* kbuf = lds + cur * BUFB;
        f32x16 p0, p1;
        if (j >= 6) {
            const LAS float* ep = eb + (32 * qh + r32 + (575 - 64 * j) - 4 * hi - 63);
#pragma unroll
            for (int r = 0; r < 16; ++r) { const int off = (r & 3) + 8 * (r >> 2); p0[r] = ep[63 - off] - m_run; p1[r] = ep[31 - off] - m_run; }
            if (type == 1 && j == 8) {
#pragma unroll
                for (int r = 0; r < 16; ++r) { if (crow(r, hi) >= SSEQ) p0[r] = -1.0e30f; p1[r] = -1.0e30f; }
            }
        } else {
#pragma unroll
            for (int r = 0; r < 16; ++r) { p0[r] = -m_run; p1[r] = -m_run; }
        }
        const LAS unsigned char* kb = kbuf + hh * 8192 + r32 * 128;
#pragma unroll
        for (int d0 = 0; d0 < 4; ++d0) {
            const int co = ((2 * d0 + hi) ^ (r32 & 7)) * 16;
            const bf16x8 k0 = *(const LAS bf16x8*)(kb + co), k1 = *(const LAS bf16x8*)(kb + 4096 + co);
            p0 = __builtin_amdgcn_mfma_f32_32x32x16_bf16(k0, qr[d0], p0, 0, 0, 0);
            p1 = __builtin_amdgcn_mfma_f32_32x32x16_bf16(k1, qr[d0], p1, 0, 0, 0);
        }
        if (!(mode & 2)) {
        float rm = fmaxf(p0[0], p1[0]);
#pragma unroll
        for (int r = 1; r < 16; ++r) rm = fmaxf(rm, fmaxf(p0[r], p1[r]));
        rm = fmaxf(rm, __shfl_xor(rm, 32));
        if (first) {
            first = false; m_run = rm;
#pragma unroll
            for (int r = 0; r < 16; ++r) { p0[r] -= rm; p1[r] -= rm; }
        } else if (__any(rm > THR)) {
            const float dl = fmaxf(rm, 0.f), alpha = __builtin_amdgcn_exp2f(-dl);
            m_run += dl; l_run *= alpha;
#pragma unroll
            for (int r = 0; r < 16; ++r) { p0[r] -= dl; p1[r] -= dl; }
            if (hi == 0) wsf[r32] = alpha;
            asm volatile("s_waitcnt lgkmcnt(0)" ::: "memory");
#pragma unroll
            for (int r = 0; r < 16; ++r) { const float al = wsf[crow(r, hi)]; o[0][r] *= al; o[1][r] *= al; }
        }
        float ls = 0.f;
#pragma unroll
        for (int r = 0; r < 16; ++r) { p0[r] = __builtin_amdgcn_exp2f(p0[r]); p1[r] = __builtin_amdgcn_exp2f(p1[r]); ls += p0[r] + p1[r]; }
        l_run += ls;
        }
        u32x4 pw[4];
#pragma unroll
        for (int q4 = 0; q4 < 4; ++q4) { pw[0][q4] = pk2(p0[2 * q4], p0[2 * q4 + 1]); pw[1][q4] = pk2(p0[8 + 2 * q4], p0[8 + 2 * q4 + 1]); pw[2][q4] = pk2(p1[2 * q4], p1[2 * q4 + 1]); pw[3][q4] = pk2(p1[8 + 2 * q4], p1[8 + 2 * q4 + 1]); }
        const int vb = (int)(unsigned)(uintptr_t)(kbuf + LV + hh * 8192 + ((lane >> 4) & 1) * 32 + (lane & 3) * 8 + (4 * hi + ((lane & 15) >> 2)) * 64);
#pragma unroll
        for (int d0 = 0; d0 < 2; ++d0) {
            s16x4 lo[4], hv[4];
#pragma unroll
            for (int ks = 0; ks < 4; ++ks) {
                asm volatile("ds_read_b64_tr_b16 %0, %1 offset:%c2" : "=&v"(lo[ks]) : "v"(vb), "i"(d0 * 4096 + ks * 1024) : "memory");
                asm volatile("ds_read_b64_tr_b16 %0, %1 offset:%c2" : "=&v"(hv[ks]) : "v"(vb), "i"(d0 * 4096 + ks * 1024 + 512) : "memory");
            }
            asm volatile("s_waitcnt lgkmcnt(0)" ::: "memory"); __builtin_amdgcn_sched_barrier(0);
#pragma unroll
            for (int ks = 0; ks < 4; ++ks) {
                const bf16x8 vf = (bf16x8){lo[ks][0], lo[ks][1], lo[ks][2], lo[ks][3], hv[ks][0], hv[ks][1], hv[ks][2], hv[ks][3]};
                o[d0] = __builtin_amdgcn_mfma_f32_32x32x16_bf16(__builtin_bit_cast(bf16x8, pw[ks]), vf, o[d0], 0, 0, 0);
            }
        }
    }
#undef ATT_DMA
    __syncthreads();
    if (wave_valid) {
        const float lt = l_run + __shfl_xor(l_run, 32);
        if (hi == 0) wsf[32 + r32] = lt;
        asm volatile("s_waitcnt lgkmcnt(0)" ::: "memory");
        LAS bf16_t* stg = (LAS bf16_t*)lds + wid * 2048;
#pragma unroll
        for (int r = 0; r < 16; ++r) { const int orow = crow(r, hi); const float rl = 1.0f / wsf[32 + orow];
            stg[orow * 64 + r32] = (bf16_t)f2bf(o[0][r] * rl); stg[orow * 64 + 32 + r32] = (bf16_t)f2bf(o[1][r] * rl); }
        asm volatile("s_waitcnt lgkmcnt(0)" ::: "memory");
#pragma unroll
        for (int i = 0; i < 4; ++i) { const int row = i * 8 + (lane >> 3), ch = lane & 7;
            if (type == 0 || row < SSEQ) {
                const u32x4 ov = *(const LAS u32x4*)(stg + row * 64 + ch * 8);
                const u32x4 gv = *(const GAS u32x4*)(SGA + (qrow0 + row) * 512 + head * 64 + ch * 8);
                u32x4 w;
#pragma unroll
                for (int c = 0; c < 4; ++c) { const float a0 = bf2f(ov[c] & 0xffffu) * bf2f(gv[c] & 0xffffu), a1 = bf2f(ov[c] >> 16) * bf2f(gv[c] >> 16); w[c] = pk2(a0, a1); }
                *(GAS u32x4*)(MIX + (qrow0 + row) * 1024 + 512 + head * 64 + ch * 8) = w; } }
    }
}

__device__ __forceinline__ void phase(const Ctx& C, LAS unsigned char* lds, GAS unsigned* qctr, int bx, int tid) {
    LAS unsigned* bc = (LAS unsigned*)(lds + 131072 + 1024);
    for (int dq = 0; dq < 8; ++dq) {
        const int x = (bx + dq) & 7;
        for (;;) {
            __syncthreads();
            if (tid == 0) bc[0] = __hip_atomic_fetch_add(qctr + x * 64, 1u, __ATOMIC_RELAXED, __HIP_MEMORY_SCOPE_AGENT);
            __syncthreads();
            const unsigned idx = bc[0];
            if (idx >= 264u) break;
            int type, seq, n, hg;
            if (idx < 8u) { type = 1; seq = 4 * x + (int)(idx >> 1); n = 0; hg = (int)(idx & 1); }
            else { const int k = (int)idx - 8, sq = 4 * x + (k >> 6); type = 0; seq = sq >> 1; n = k & 63; hg = sq & 1; }
#if defined(PROBE_REGION)
            { const unsigned long long t0_ = __builtin_amdgcn_s_memrealtime();
              unit(C, lds, type, seq, n, hg, tid);
              __syncthreads();
              if (tid == 0) { volatile LAS unsigned long long* pr = (volatile LAS unsigned long long*)(lds + 131072 + 3072);
                  const bool match = (PROBE_REGION == 2) ? (type == 0 && n >= 8 && pr[1] == 0ull) : (PROBE_REGION == 3) ? (type == 1 && pr[1] == 0ull) : false;
                  if (match) { pr[0] += 8ull * (__builtin_amdgcn_s_memrealtime() - t0_); pr[1] = 1ull; } } }
#else
            unit(C, lds, type, seq, n, hg, tid);
#endif
        }
    }
#if defined(PROBE_MODE)
    if (bx == 0) for (int rep = 0; rep < 64; ++rep) unit(C, lds, 0, 0, 16 + (rep & 31), 0, tid, PROBE_MODE);
#endif
}
}
namespace s5 {
constexpr int HKB = 1040;
constexpr int WLDS = 8192 + 4 * HKB;
static_assert(8 * WLDS <= 131072, "s5 lds");
struct Ctx { const GAS unsigned char* ws; const GAS float* st_re; const GAS float* st_im; GAS float* out; int layer; };

__device__ __forceinline__ void unit(const Ctx& C, LAS unsigned char* wl, int type, int seq, int c, int g, int lane) {
    const int fr = lane & 15, fq = lane >> 4;
    const GAS unsigned char* tb = C.ws + WS_TAB + (size_t)C.layer * TAB_L;
    const GAS bf16_t* U = (const GAS bf16_t*)(C.ws + WS_U); GAS bf16_t* YG = (GAS bf16_t*)(C.ws + WS_YG);
    bf16x8 bu[8], cm[4], dmat;
#pragma unroll
    for (int cb = 0; cb < 8; ++cb) bu[cb] = *(const GAS bf16x8*)(tb + T_BU + ((size_t)(g * 8 + cb) * 64 + lane) * 16);
#pragma unroll
    for (int kb = 0; kb < 4; ++kb) cm[kb] = *(const GAS bf16x8*)(tb + T_C + ((size_t)(g * 4 + kb) * 64 + lane) * 16);
    dmat = *(const GAS bf16x8*)(tb + T_D + ((size_t)g * 64 + lane) * 16);
    const f32x2 ab = *(const GAS f32x2*)(tb + T_AB + ((size_t)g * 64 + lane) * 8);
    float hr, hi; long row0; int nrb;
    if (type == 0) { const f32x2 h0 = *(const GAS f32x2*)(C.ws + WS_HIN + ((((size_t)seq * NCH + c) * NG + g) * NP + lane) * 8); hr = h0.x; hi = h0.y; row0 = (long)seq * SEQ + c * 64; nrb = 4; }
    else { const size_t si = ((size_t)(C.layer * SBAT + seq) * NG + g) * NP + lane; hr = C.st_re[si]; hi = C.st_im[si]; row0 = (long)MP + seq * SSEQ; nrb = 1; }
    LAS unsigned char* hb = wl + 8192;
    for (int rb = 0; rb < nrb; ++rb) {
        const bf16x8 ua = *(const GAS bf16x8*)(U + (row0 + rb * 16 + fr) * 512 + g * 16 + (fq & 1) * 8);
#pragma unroll
        for (int j = 0; j < 4; ++j) {
            const f32x4 z = {0.f, 0.f, 0.f, 0.f};
            const f32x4 re = __builtin_amdgcn_mfma_f32_16x16x32_bf16(ua, bu[2 * j], z, 0, 0, 0);
            const f32x4 im = __builtin_amdgcn_mfma_f32_16x16x32_bf16(ua, bu[2 * j + 1], z, 0, 0, 0);
#pragma unroll
            for (int r = 0; r < 4; ++r) *(LAS f32x2*)(wl + (4 * fq + r) * 512 + (16 * j + fr) * 8) = (f32x2){re[r], im[r]};
        }
#pragma unroll
        for (int t = 0; t < 16; ++t) {
            const f32x2 b = *(const LAS f32x2*)(wl + t * 512 + lane * 8);
            const float nr = ab.x * hr - ab.y * hi + b.x, ni = ab.x * hi + ab.y * hr + b.y;
            hr = nr; hi = ni;
            *(LAS unsigned*)(hb + (lane >> 4) * HKB + t * 64 + (lane & 15) * 4) = pk2(hr, hi);
        }
        f32x4 y = {0.f, 0.f, 0.f, 0.f};
#pragma unroll
        for (int kb = 0; kb < 4; ++kb) { const bf16x8 ha = *(const LAS bf16x8*)(hb + kb * HKB + fr * 64 + fq * 16); y = __builtin_amdgcn_mfma_f32_16x16x32_bf16(ha, cm[kb], y, 0, 0, 0); }
        y = __builtin_amdgcn_mfma_f32_16x16x32_bf16(ua, dmat, y, 0, 0, 0);
#pragma unroll
        for (int r = 0; r < 4; ++r) YG[(row0 + rb * 16 + 4 * fq + r) * 512 + g * 16 + fr] = (bf16_t)f2bf(gelu_tanh(y[r]));
    }
    if (type == 1) { const size_t o = ((size_t)(C.layer * SBAT + seq) * NG + g) * NP + lane; C.out[O_RS + o] = hr; C.out[O_IS + o] = hi; }
}
__device__ __forceinline__ void phase(const Ctx& C, LAS unsigned char* lds, int vcu, int G, int tid) {
    const int lane = tid & 63, wave = __builtin_amdgcn_readfirstlane(tid >> 6);
    LAS unsigned char* wl = lds + wave * WLDS;
    const int gw = vcu * 8 + wave, NGW = G * 8;
    for (int u = gw; u < NB * NCH * NG + SBAT * NG; u += NGW) {
        if (u < NB * NCH * NG) unit(C, wl, 0, u >> 11, (u >> 5) & 63, u & 31, lane);
        else { const int v = u - NB * NCH * NG; unit(C, wl, 1, v >> 5, 0, v & 31, lane); }
    }
}
}
typedef GAS unsigned gu32;
#define XB_TMO      128
#define XB_XCNT(j)  (256  + 64 * (j))
#define XB_XSUB(j)  (1280 + 64 * (j))
#define XB_XGEN(j)  (2304 + 64 * (j))
#define XB_TOP      3328
#define XB_TOPGEN   3392
#define XCD_BAR_WORDS 3456
#define XB_SPIN_CAP (1u << 18)

__device__ __forceinline__ unsigned xb_ld(unsigned* p)              { return __hip_atomic_load(p, __ATOMIC_RELAXED, __HIP_MEMORY_SCOPE_AGENT); }
__device__ __forceinline__ unsigned xb_add(unsigned* p, unsigned v) { return __hip_atomic_fetch_add(p, v, __ATOMIC_RELAXED, __HIP_MEMORY_SCOPE_AGENT); }
__device__ __forceinline__ unsigned xb_xcc_id() { return (unsigned)__builtin_amdgcn_s_getreg((3 << 11) | 20) & 0xFu; }
#define XB_SPIN(cond, bar) do { unsigned _sp = 0; while (cond) { __builtin_amdgcn_s_sleep(1); \
    if ((++_sp & 255u) == 0u) { if (xb_ld(&(bar)[XB_TMO])) break; if (_sp > XB_SPIN_CAP) { atomicAdd(&(bar)[XB_TMO], 1u); break; } } } } while (0)

struct XcdBarrier {
    unsigned* bar; unsigned x;
    volatile LAS unsigned* st;
};

__device__ __forceinline__ XcdBarrier xcd_barrier_post(unsigned* bar, volatile LAS unsigned* st) {
    XcdBarrier b; b.bar = bar; b.x = xb_xcc_id(); b.st = st;
    if (threadIdx.x == 0) (void)xb_add(&bar[XB_XCNT(b.x)], 1u);
    return b;
}
__device__ __forceinline__ void xcd_barrier_complete(unsigned* bar, unsigned x, unsigned& nloc, unsigned& nx) {
    const unsigned G = gridDim.x * gridDim.y * gridDim.z;
    unsigned sum, cnt, mine, sp = 0u;
    for (;;) {
        sum = 0u; cnt = 0u; mine = 0u;
#pragma unroll
        for (unsigned j = 0; j < 16; ++j) { const unsigned c = xb_ld(&bar[XB_XCNT(j)]); sum += c; cnt += (c > 0u) ? 1u : 0u; mine = (j == x) ? c : mine; }
        if (sum == G) break;
        __builtin_amdgcn_s_sleep(1);
        if ((++sp & 255u) == 0u) { if (xb_ld(&bar[XB_TMO])) break; if (sp > XB_SPIN_CAP) { atomicAdd(&bar[XB_TMO], 1u); break; } }
    }
    nloc = mine > 0u ? mine : 1u; nx = cnt > 0u ? cnt : 1u;
}

__device__ __forceinline__ void xcd_barrier(const XcdBarrier& b) {
    asm volatile("s_waitcnt vmcnt(0)" ::: "memory");
    __syncthreads();
    if (threadIdx.x == 0) {
        unsigned* bar = b.bar;
        __builtin_amdgcn_s_waitcnt(0);
        unsigned nloc = b.st[0], nx = b.st[1];
        if (nloc == 0u) { xcd_barrier_complete(bar, b.x, nloc, nx); b.st[0] = nloc; b.st[1] = nx; }
        const unsigned old = xb_add(&bar[XB_XSUB(b.x)], 1u);
        const unsigned gen = old / nloc;
        if (old + 1u == (gen + 1u) * nloc) {
            __builtin_amdgcn_fence(__ATOMIC_RELEASE, "agent");
            asm volatile("s_waitcnt vmcnt(0)" ::: "memory");
            const unsigned og = xb_add(&bar[XB_TOP], 1u);
            const unsigned tg = og / nx;
            if (og + 1u == (tg + 1u) * nx) xb_add(&bar[XB_TOPGEN], 1u);
            else XB_SPIN(xb_ld(&bar[XB_TOPGEN]) == tg, bar);
            __builtin_amdgcn_fence(__ATOMIC_ACQUIRE, "agent");
            xb_add(&bar[XB_XGEN(b.x)], 1u);
            asm volatile("s_waitcnt vmcnt(0)" ::: "memory");
        } else {
            XB_SPIN(xb_ld(&bar[XB_XGEN(b.x)]) == gen, bar);
            __builtin_amdgcn_fence(__ATOMIC_ACQUIRE, "agent");
            asm volatile("s_waitcnt vmcnt(0)" ::: "memory");
        }
    }
    __syncthreads();
}

#ifndef PHMASK
#define PHMASK 0xFF
#endif
constexpr int LDS_BYTES = 147456;
constexpr int NPHASE = 1 + 5 * NL;
struct Args { InPtrs in; float* out; unsigned char* ws; int ph_lo, ph_hi; };

#ifndef PROBE_PH
#define PROBE_PH -1
#endif
#ifndef N_CG_SYNC
#define N_CG_SYNC 1
#endif
template <bool COOP>
__global__ void __launch_bounds__(512, 2) fwd(Args a) {
    extern __shared__ __attribute__((aligned(16))) unsigned char lds_raw[];
    LAS unsigned char* lds = (LAS unsigned char*)lds_raw;
    const int tid = threadIdx.x, G = gridDim.x, bx = blockIdx.x;
    const int vcu = (G % 8 == 0) ? (bx % 8) * (G / 8) + bx / 8 : bx;
    volatile LAS unsigned* MISC = (volatile LAS unsigned*)(lds + 131072 + 2048);
    XcdBarrier bar; bar.bar = nullptr; bar.x = 0; bar.st = nullptr;
    unsigned long long t_probe = 0, t_last = 0;
    if constexpr (COOP) {
        if (tid < 16) MISC[tid] = 0u;
        if (tid < 8) ((volatile LAS unsigned*)(lds + 131072 + 3072))[tid] = 0u;
        __syncthreads();
        bar = xcd_barrier_post((unsigned*)(a.ws + WS_CTL) + CW_BAR, MISC + 8);
        if (PROBE_PH >= 0) t_last = __builtin_amdgcn_s_memrealtime();
    }
    int seam = 0;
#define SEAM() do { if constexpr (COOP) { if (seam < N_CG_SYNC) cg::this_grid().sync(); else xcd_barrier(bar); ++seam; } } while (0)
#define STAMP(ph_) do { if constexpr (COOP) { if (PROBE_PH >= 0) { const unsigned long long now_ = __builtin_amdgcn_s_memrealtime(); if ((ph_) == PROBE_PH) t_probe = now_ - t_last; t_last = now_; } } } while (0)
    if (a.ph_lo == 0) {
        unsigned char* ws = a.ws; asm volatile("" : "+s"(ws));
        p0_prologue(ws, lds, vcu, G, tid);
        if (a.ph_hi > 1) SEAM();
        STAMP(0);
    }
    for (int ph = (a.ph_lo < 1 ? 1 : a.ph_lo); ph < a.ph_hi; ++ph) {
        unsigned char* ws = a.ws; float* out = a.out; asm volatile("" : "+s"(ws), "+s"(out));
        {
            const int l = (ph - 1) / 5, k = (ph - 1) % 5;
#ifndef KMASK
#define KMASK 31
#endif
            if (k == 0 && (KMASK & 1)) {
                pg8::GemmStd g{(const char*)(ws + WS_XB), (const char*)(ws + WS_WIN + l * WIN_L), DM};
                pg8::StaticOrder S; S.init(MT, DIN, G, bx);
                pg8::EpiInProj E{(const float*)(ws + WS_ROWSS), ws, a.in.p[17] + l * HD, a.in.p[18] + l * HD, out, l};
                pg8::gemm_phase<pg8::EpiInProj, pg8::StaticOrder, pg8::GemmStd, true, true>(lds, g, S, E);
            } else if (k == 1 && (KMASK & 2)) {
                {
#if defined(PROBE_REGION)
                    const unsigned long long t0_ = __builtin_amdgcn_s_memrealtime();
#endif
                    pg8::GemmPassA g{(const char*)(ws + WS_U), (const char*)(ws + WS_PM + l * PM_L)};
                    pg8::OneUnitOrder S{NG * 4, bx};
                    pg8::EpiPassA E{(const f32x2*)(ws + WS_TAB + l * TAB_L + T_A64), (f32x2*)(ws + WS_HIN), out, l};
                    pg8::gemm_phase<pg8::EpiPassA, pg8::OneUnitOrder, pg8::GemmPassA, false, true>(lds, g, S, E);
#if defined(PROBE_REGION)
                    if (PROBE_REGION == 1 && l == 0 && tid == 0) ((volatile LAS unsigned long long*)(lds + 131072 + 3072))[0] += 8ull * (__builtin_amdgcn_s_memrealtime() - t0_);
#endif
                }
                int tid_ = threadIdx.x; asm volatile("" : "+v"(tid_));
                att::Ctx C{(const GAS unsigned char*)ws, (const GAS float*)a.in.p[2], (const GAS float*)a.in.p[3], l};
                att::phase(C, lds, (GAS unsigned*)(ws + WS_CTL) + CW_QUEUE + l * 512, bx, tid_);
            } else if (k == 2 && (KMASK & 4)) {
                int tid_ = threadIdx.x; asm volatile("" : "+v"(tid_));
                s5::Ctx C{(const GAS unsigned char*)ws, (const GAS float*)a.in.p[4], (const GAS float*)a.in.p[5], (GAS float*)out, l};
                s5::phase(C, lds, vcu, G, tid_);
            } else if (k == 3 && (KMASK & 8)) {
                pg8::GemmStd g{(const char*)(ws + WS_YG), (const char*)(ws + WS_WGLU + l * WGLU_L), DS};
                pg8::StaticOrder S; S.init(MT, 2 * DS, G, bx);
                pg8::EpiGlu E{(const bf16_t*)(ws + WS_SG), (bf16_t*)(ws + WS_MIX)};
                pg8::gemm_phase<pg8::EpiGlu, pg8::StaticOrder, pg8::GemmStd, true, true>(lds, g, S, E);
            } else if (KMASK & 16) {
                pg8::GemmStd g{(const char*)(ws + WS_MIX), (const char*)(ws + WS_WOUT + l * WOUT_L), DM};
                pg8::StaticOrder S; S.init(MT, DM, G, bx);
                pg8::EpiOut E{a.in.p[0], a.in.p[1], out + O_YP, out + O_YS, (bf16_t*)(ws + WS_XB), (float*)(ws + WS_ROWSS), l == 0 ? 1 : 0};
                pg8::gemm_phase<pg8::EpiOut, pg8::StaticOrder, pg8::GemmStd, true, true>(lds, g, S, E);
            }
        }
        if (ph + 1 < a.ph_hi) SEAM();
        else if (PROBE_PH >= 0) { if constexpr (COOP) xcd_barrier(bar); }
        STAMP(ph);
    }
#if defined(PROBE_REGION)
    if constexpr (COOP) { __syncthreads(); if (bx == 0 && tid == 0) { const unsigned long long d_ = ((volatile LAS unsigned long long*)(lds + 131072 + 3072))[0]; const unsigned long long t0 = __builtin_amdgcn_s_memrealtime(); while (__builtin_amdgcn_s_memrealtime() - t0 < d_) __builtin_amdgcn_s_sleep(8); } }
#endif
    if constexpr (COOP) { if (PROBE_PH >= 0 && bx == 0 && tid == 0) { const unsigned long long t0 = __builtin_amdgcn_s_memrealtime(); while (__builtin_amdgcn_s_memrealtime() - t0 < t_probe) __builtin_amdgcn_s_sleep(8); } }
#undef SEAM
#undef STAMP
}

#ifndef MK_ONE_LAUNCH
#define MK_ONE_LAUNCH 1
#endif
extern "C" void kernel_launch(void* const* d_in, const int* in_sizes, int n_in, void* d_out, int out_size, void* d_ws, size_t ws_size, hipStream_t stream) {
    static int grid = 0;
    if (grid == 0) {
        if (n_in != 21 || (size_t)out_size != O_END || ws_size < WS_END) { fprintf(stderr, "kernel_launch: unexpected shapes (n_in %d out %d ws %zu)\n", n_in, out_size, ws_size); grid = -1; return; }
        int dev = 0, cus = 0, per_cu = 0;
        (void)hipGetDevice(&dev); (void)hipDeviceGetAttribute(&cus, hipDeviceAttributeMultiprocessorCount, dev);
        (void)hipFuncSetAttribute((const void*)fwd<false>, hipFuncAttributeMaxDynamicSharedMemorySize, LDS_BYTES);
        (void)hipFuncSetAttribute((const void*)fwd<true>, hipFuncAttributeMaxDynamicSharedMemorySize, LDS_BYTES);
        (void)hipOccupancyMaxActiveBlocksPerMultiprocessor(&per_cu, (const void*)fwd<true>, 512, LDS_BYTES);
        if (per_cu < 1) { fprintf(stderr, "kernel_launch: occupancy query says %d blocks per CU\n", per_cu); per_cu = 1; }
        (void)hipGetLastError();
        grid = cus;
    }
    if (grid < 0) return;
    (void)hipMemsetAsync((char*)d_ws + WS_CTL, 0, CTL_BYTES, stream);
    Args a{};
    for (int i = 0; i < 21; ++i) a.in.p[i] = (const float*)d_in[i];
    a.out = (float*)d_out; a.ws = (unsigned char*)d_ws;
#if MK_ONE_LAUNCH
    a.ph_lo = 0; a.ph_hi = NPHASE;
    void* args[] = {&a};
    hipError_t e = hipLaunchCooperativeKernel((const void*)fwd<true>, dim3(grid), dim3(512), args, LDS_BYTES, stream);
    if (e != hipSuccess) fprintf(stderr, "cooperative launch failed: %s (grid %d)\n", hipGetErrorString(e), grid);
#else
    for (int ph = 0; ph < NPHASE; ++ph) { a.ph_lo = ph; a.ph_hi = ph + 1; hipLaunchKernelGGL(fwd<false>, dim3(grid), dim3(512), LDS_BYTES, stream, a); }
#endif
}
```

```cpp
#include <hip/hip_runtime.h>
#include <hip/hip_cooperative_groups.h>
#include <cstdio>
#include <cstdint>
#include <cmath>
namespace cg = cooperative_groups;

#define LAS __attribute__((address_space(3)))
#define GAS __attribute__((address_space(1)))
typedef unsigned short bf16_t;
typedef short bf16x8 __attribute__((ext_vector_type(8)));
typedef short s16x4 __attribute__((ext_vector_type(4)));
typedef float f32x2 __attribute__((ext_vector_type(2)));
typedef float f32x4 __attribute__((ext_vector_type(4)));
typedef float f32x16 __attribute__((ext_vector_type(16)));
typedef unsigned u32x2 __attribute__((ext_vector_type(2)));
typedef unsigned u32x4 __attribute__((ext_vector_type(4)));

constexpr int DM = 1024, NB = 16, SEQ = 4096, NL = 2, SBAT = 32, SSEQ = 16, PAST = 512;
constexpr int MP = NB * SEQ, MS = SBAT * SSEQ, MT = MP + MS;
constexpr int DS = 512, NG = 32, NP = 64, NCHN = 16, NH = 8, HD = 64, DIN = 3072, NREL = 257;
constexpr int NCH = SEQ / 64;
constexpr float EPS = 1e-6f;
constexpr float LOG2E = 1.4426950408889634f;
constexpr float QSCALE = 0.125f * LOG2E;

constexpr size_t O_YP = 0, O_YS = 67108864, O_KP = 67633152, O_VP = 76021760, O_RP = 84410368, O_IP = 84475904,
                 O_KS = 84541440, O_VS = 85065728, O_RS = 85590016, O_IS = 85721088, O_END = 85852160;

constexpr size_t MiB = 1u << 20;
constexpr size_t WS_CTL = 0, CTL_BYTES = 1 * MiB;
constexpr size_t WS_WIN = 1 * MiB, WIN_L = 6 * MiB;
constexpr size_t WS_WGLU = 13 * MiB, WGLU_L = 1 * MiB;
constexpr size_t WS_WOUT = 15 * MiB, WOUT_L = 2 * MiB;
constexpr size_t WS_TAB = 19 * MiB, TAB_L = 2 * MiB;
constexpr size_t WS_PM = 24 * MiB, PM_L = 16 * MiB;
constexpr size_t WS_ROWSS = 56 * MiB;
constexpr size_t WS_HIN = 61 * MiB;
constexpr size_t WS_XB = 77 * MiB;
constexpr size_t ACT_STRIDE = 65 * MiB;
constexpr size_t WS_U = 206 * MiB, WS_SG = WS_U + ACT_STRIDE, WS_Q = WS_SG + ACT_STRIDE, WS_K = WS_Q + ACT_STRIDE, WS_V = WS_K + ACT_STRIDE,
                 WS_SGA = WS_V + ACT_STRIDE, WS_YG = WS_SGA + ACT_STRIDE, WS_MIX = WS_YG + ACT_STRIDE, WS_END = WS_MIX + 129 * MiB;
static_assert(WS_END <= 1024 * MiB, "workspace");
constexpr size_t T_AB = 0, T_A64 = 16384, T_BU = 32768, T_D = T_BU + 262144, T_C = T_D + 32768, T_BIAS = T_C + 131072, T_END = T_BIAS + 524288;
static_assert(T_END <= TAB_L, "tables");
constexpr int CW_QUEUE = 1024;
constexpr int CW_BAR = 8192;

__device__ __forceinline__ unsigned f2bf(float f) { unsigned u = __builtin_bit_cast(unsigned, f); return (u + 0x7fffu + ((u >> 16) & 1u)) >> 16; }
__device__ __forceinline__ float bf2f(unsigned h) { return __builtin_bit_cast(float, h << 16); }
typedef __bf16 bf16x2_t __attribute__((ext_vector_type(2)));
__device__ __forceinline__ unsigned pk2(float lo, float hi) { const f32x2 v = {lo, hi}; const bf16x2_t b = __builtin_convertvector(v, bf16x2_t); return __builtin_bit_cast(unsigned, b); }
__device__ __forceinline__ float silu_f(float x) { return x / (1.0f + __expf(-x)); }
__device__ __forceinline__ float sigmoid_f(float x) { return 1.0f / (1.0f + __expf(-x)); }
__device__ __forceinline__ float gelu_tanh(float x) { const float u = 0.7978845608028654f * (x + 0.044715f * x * x * x); const float e = __expf(2.0f * u); const float t = 1.0f - 2.0f / (e + 1.0f); return 0.5f * x * (1.0f + t); }
namespace pg8 {
#define PG8_LAS __attribute__((address_space(3)))
constexpr int BM = 256, BK = 64, HALF = 128, HTB = HALF * BK * 2  , STAGE_BYTES = 8 * HTB, NXCD = 8, WGM = 8;

__host__ __device__ __forceinline__ int lds_byte(int r, int c) { const int st = (r >> 4) * 2 + (c >> 5), rr = r & 15, cc = c & 31, ob = rr * 64 + cc * 2; return st * 1024 + (ob ^ (((ob >> 9) & 1) << 5)); }
__host__ __device__ __forceinline__ void stage_rc(int b, int& R, int& C) { const int st = b / 1024, sb = b % 1024, swz = sb ^ (((sb >> 9) & 1) << 5); R = (st >> 1) * 16 + swz / 64; C = (st & 1) * 32 + (swz % 64) / 2; }
__host__ __device__ __forceinline__ int perm32(int rho) { const int n = rho >> 4, i = rho & 15; return 8 * (i >> 2) + 4 * n + (i & 3); }

struct Unit { int pm, pn; };

struct GemmStd {
    const char* A; const char* Bt; int K;
    __device__ __forceinline__ const char* a_base(const Unit& u) const { return A + (size_t)u.pm * BM * K * 2; }
    __device__ __forceinline__ const char* b_base(const Unit& u) const { return Bt + (size_t)u.pn * BM * K * 2; }
    __device__ __forceinline__ unsigned a_voff(int R, int C) const { return (unsigned)(R * K + C) * 2u; }
    __device__ __forceinline__ unsigned b_voff(int R, int C) const { return (unsigned)(R * K + C) * 2u; }
    __device__ __forceinline__ size_t a_kstep() const { return BK * 2; }
    __device__ __forceinline__ size_t b_kstep() const { return BK * 2; }
    __device__ __forceinline__ size_t a_hstep() const { return (size_t)HALF * K * 2; }
    __device__ __forceinline__ size_t b_hstep() const { return (size_t)HALF * K * 2; }
    __device__ __forceinline__ int nt() const { return K / BK; }
};
struct GemmPassA {
    const char* U; const char* PM;
    __device__ __forceinline__ const char* a_base(const Unit& u) const { return U + (size_t)(u.pm >> 2) * ((size_t)MT * 32) + (size_t)(u.pm & 3) * 256 * 2048; }
    __device__ __forceinline__ const char* b_base(const Unit& u) const { return PM + (size_t)(u.pm >> 2) * (256 * 1024 * 2); }
    __device__ __forceinline__ unsigned a_voff(int R, int C) const { return (unsigned)(R * 1024 + C) * 2u; }
    __device__ __forceinline__ unsigned b_voff(int R, int C) const { return (unsigned)(R * 1024 + C) * 2u; }
    __device__ __forceinline__ size_t a_kstep() const { return BK * 2; }
    __device__ __forceinline__ size_t b_kstep() const { return BK * 2; }
    __device__ __forceinline__ size_t a_hstep() const { return (size_t)HALF * 2048; }
    __device__ __forceinline__ size_t b_hstep() const { return (size_t)HALF * 1024 * 2; }
    __device__ __forceinline__ int nt() const { return 16; }
};

struct StaticOrder {
    int nM, nN, nwg, G, c, tn, tpm0;
    __host__ __device__ void init(int M, int N, int G_, int c_) { nM = M / BM; nN = N / BM; nwg = nM * nN; G = G_; c = c_; tn = 0; tpm0 = 0; }
    __host__ __device__ void init_team(int N, int n_units, int pm0, int c_) { nM = 0; nN = N / BM; nwg = 0; G = 1; c = c_; tn = n_units; tpm0 = pm0; }
    __host__ __device__ bool next(int i, Unit& u) const {
        if (tn > 0) { if (i != 0 || c < 0 || c >= tn) return false; u.pm = tpm0 + c / nN; u.pn = c % nN; return true; }
        const long L = (long)i * G + c; if (L >= nwg) return false;
        int wgid = (int)L; { const int q = nwg / NXCD, r = nwg % NXCD, xcd = wgid % NXCD, off = wgid / NXCD; wgid = (xcd < r ? xcd * (q + 1) : r * (q + 1) + (xcd - r) * q) + off; }
        const int nig = WGM * nN, gid = wgid / nig, fm = gid * WGM, gsz = (nM - fm) < WGM ? (nM - fm) : WGM;
        u.pm = fm + ((wgid % nig) % gsz); u.pn = (wgid % nig) / gsz; return true;
    }
    __device__ __forceinline__ void a_ready(const Unit&) const {}
    __device__ __forceinline__ void done(const Unit&) const {}
};
struct OneUnitOrder {
    int n, c;
    __device__ __forceinline__ bool next(int i, Unit& u) const { if (i != 0 || c < 0 || c >= n) return false; u.pm = c; u.pn = 0; return true; }
    __device__ __forceinline__ void a_ready(const Unit&) const {}
    __device__ __forceinline__ void done(const Unit&) const {}
};


struct EpiInProj {
    static constexpr bool PERM = false, AFTER_DRAIN = false, HAS_INIT = false;
    const float* rowss; unsigned char* ws; const float* qg; const float* kg; float* out; int layer;
    __device__ __forceinline__ void operator()(const f32x4 (&acc)[2][2][4][2], const Unit& u, int wr, int wc, int fr, int fq) const {
        const int kind = u.pn >> 1;
        bf16_t* dst = (bf16_t*)(ws + WS_U + (size_t)kind * ACT_STRIDE);
        const int colb = (u.pn & 1) * 256 + wc * 64 + fq * 16;
        float gv[16];
#pragma unroll
        for (int e = 0; e < 16; ++e) gv[e] = 1.f;
        if (kind == 2 || kind == 3) { const float* gp = (kind == 2 ? qg : kg) + fq * 16;
#pragma unroll
            for (int e4 = 0; e4 < 4; ++e4) { const f32x4 t = *(const GAS f32x4*)(gp + 4 * e4); gv[4 * e4] = t.x; gv[4 * e4 + 1] = t.y; gv[4 * e4 + 2] = t.z; gv[4 * e4 + 3] = t.w; }
            if (kind == 2) {
#pragma unroll
                for (int e = 0; e < 16; ++e) gv[e] *= QSCALE; } }
        const bool want_out = (kind == 3 || kind == 4) && (u.pm >= 256 || (u.pm & 15) >= 14);
        float* ob = out + (kind == 3 ? (u.pm >= 256 ? O_KS : O_KP) : (u.pm >= 256 ? O_VS : O_VP));
#pragma unroll
        for (int ai = 0; ai < 2; ++ai)
#pragma unroll
            for (int m = 0; m < 4; ++m) {
                const int row = u.pm * BM + ai * HALF + wr * 64 + m * 16 + fr;
                const f32x4 pr = *(const GAS f32x4*)(rowss + (size_t)row * 16 + fq * 4);
                float ss = (pr.x + pr.y) + (pr.z + pr.w); ss += __shfl_xor(ss, 16); ss += __shfl_xor(ss, 32);
                const float rstd = rsqrtf(ss * (1.0f / 1024.0f) + EPS);
                float v[16];
#pragma unroll
                for (int bj = 0; bj < 2; ++bj)
#pragma unroll
                    for (int n = 0; n < 2; ++n)
#pragma unroll
                        for (int i = 0; i < 4; ++i) v[8 * bj + 4 * n + i] = acc[ai][bj][m][n][i] * rstd;
                if (kind == 1 || kind == 5) {
#pragma unroll
                    for (int e = 0; e < 16; ++e) v[e] = silu_f(v[e]);
                } else if (kind == 2 || kind == 3) {
                    float q = 0.f;
#pragma unroll
                    for (int e = 0; e < 16; ++e) q += v[e] * v[e];
                    q += __shfl_xor(q, 16); q += __shfl_xor(q, 32);
                    const float r = rsqrtf(q * (1.0f / 64.0f) + EPS);
#pragma unroll
                    for (int e = 0; e < 16; ++e) v[e] = v[e] * r * gv[e];
                }
                u32x4 w0, w1;
                w0.x = pk2(v[0], v[1]); w0.y = pk2(v[2], v[3]); w0.z = pk2(v[4], v[5]); w0.w = pk2(v[6], v[7]);
                w1.x = pk2(v[8], v[9]); w1.y = pk2(v[10], v[11]); w1.z = pk2(v[12], v[13]); w1.w = pk2(v[14], v[15]);
                bf16_t* dp = (kind == 0) ? dst + ((size_t)((u.pn & 1) * 16 + wc * 4 + fq) * MT + row) * 16 : dst + (size_t)row * 512 + colb;
                *(GAS u32x4*)dp = w0; *(GAS u32x4*)(dp + 8) = w1;
                if (want_out) {
                    long orow = -1;
                    if (row >= MP) orow = (long)layer * MS + (row - MP);
                    else { const int t = row & (SEQ - 1); if (t >= SEQ - PAST) orow = ((long)layer * NB + (row >> 12)) * PAST + (t - (SEQ - PAST)); }
                    if (orow >= 0) { float* op = ob + orow * 512 + colb;
                        float vo[16];
#pragma unroll
                        for (int e = 0; e < 16; ++e) vo[e] = (kind == 3) ? v[e] : v[e];
#pragma unroll
                        for (int e4 = 0; e4 < 4; ++e4) *(GAS f32x4*)(op + 4 * e4) = (f32x4){vo[4 * e4], vo[4 * e4 + 1], vo[4 * e4 + 2], vo[4 * e4 + 3]}; }
                }
            }
    }
};

struct EpiGlu {
    static constexpr bool PERM = false, AFTER_DRAIN = false, HAS_INIT = false;
    const bf16_t* SG; bf16_t* MIX;
    __device__ __forceinline__ void operator()(const f32x4 (&acc)[2][2][4][2], const Unit& u, int wr, int wc, int fr, int fq) const {
        const int col = u.pn * 128 + wc * 32 + fq * 8;
#pragma unroll
        for (int ai = 0; ai < 2; ++ai)
#pragma unroll
            for (int m = 0; m < 4; ++m) {
                const int row = u.pm * BM + ai * HALF + wr * 64 + m * 16 + fr;
                const u32x4 sg = *(const GAS u32x4*)(SG + (size_t)row * 512 + col);
                float o[8];
#pragma unroll
                for (int n = 0; n < 2; ++n)
#pragma unroll
                    for (int i = 0; i < 4; ++i) { const int e = 4 * n + i; const unsigned sw = sg[e >> 1]; const float s = bf2f((e & 1) ? (sw >> 16) : (sw & 0xffffu));
                        o[e] = acc[ai][0][m][n][i] * sigmoid_f(acc[ai][1][m][n][i]) * s; }
                u32x4 w; w.x = pk2(o[0], o[1]); w.y = pk2(o[2], o[3]); w.z = pk2(o[4], o[5]); w.w = pk2(o[6], o[7]);
                *(GAS u32x4*)(MIX + (size_t)row * 1024 + col) = w;
            }
    }
};

struct EpiOut {
    static constexpr bool PERM = false, AFTER_DRAIN = false, HAS_INIT = true;
    const float* resP; const float* resS; float* outP; float* outS; bf16_t* XB; float* rowss; int first;
    __device__ __forceinline__ void init(f32x4 (&acc)[2][2][4][2], const Unit& u, int wr, int wc, int fr, int fq) const {
        const int col = u.pn * 256 + wc * 64 + fq * 16;
#pragma unroll
        for (int ai = 0; ai < 2; ++ai)
#pragma unroll
            for (int m = 0; m < 4; ++m) {
                const int row = u.pm * BM + ai * HALF + wr * 64 + m * 16 + fr;
                if (first) { const float* rp = (row < MP) ? resP + (size_t)row * DM + col : resS + (size_t)(row - MP) * DM + col;
#pragma unroll
                    for (int bj = 0; bj < 2; ++bj)
#pragma unroll
                        for (int n = 0; n < 2; ++n) acc[ai][bj][m][n] = *(const GAS f32x4*)(rp + 8 * bj + 4 * n);
                } else { const bf16_t* xp = XB + (size_t)row * DM + col;
#pragma unroll
                    for (int bj = 0; bj < 2; ++bj) { const u32x4 w = *(const GAS u32x4*)(xp + 8 * bj);
                        acc[ai][bj][m][0] = (f32x4){bf2f(w.x & 0xffffu), bf2f(w.x >> 16), bf2f(w.y & 0xffffu), bf2f(w.y >> 16)};
                        acc[ai][bj][m][1] = (f32x4){bf2f(w.z & 0xffffu), bf2f(w.z >> 16), bf2f(w.w & 0xffffu), bf2f(w.w >> 16)}; }
                }
            }
    }
    __device__ __forceinline__ void operator()(const f32x4 (&acc)[2][2][4][2], const Unit& u, int wr, int wc, int fr, int fq) const {
        const int col = u.pn * 256 + wc * 64 + fq * 16;
#pragma unroll
        for (int ai = 0; ai < 2; ++ai)
#pragma unroll
            for (int m = 0; m < 4; ++m) {
                const int row = u.pm * BM + ai * HALF + wr * 64 + m * 16 + fr;
                if (first) {
                    float ss = 0.f;
#pragma unroll
                    for (int bj = 0; bj < 2; ++bj)
#pragma unroll
                        for (int n = 0; n < 2; ++n) { const f32x4 t = acc[ai][bj][m][n]; ss += (t.x * t.x + t.y * t.y) + (t.z * t.z + t.w * t.w); }
                    ss += __shfl_xor(ss, 16); ss += __shfl_xor(ss, 32);
                    u32x4 w0, w1;
                    w0.x = pk2(acc[ai][0][m][0].x, acc[ai][0][m][0].y); w0.y = pk2(acc[ai][0][m][0].z, acc[ai][0][m][0].w); w0.z = pk2(acc[ai][0][m][1].x, acc[ai][0][m][1].y); w0.w = pk2(acc[ai][0][m][1].z, acc[ai][0][m][1].w);
                    w1.x = pk2(acc[ai][1][m][0].x, acc[ai][1][m][0].y); w1.y = pk2(acc[ai][1][m][0].z, acc[ai][1][m][0].w); w1.z = pk2(acc[ai][1][m][1].x, acc[ai][1][m][1].y); w1.w = pk2(acc[ai][1][m][1].z, acc[ai][1][m][1].w);
                    bf16_t* xp = XB + (size_t)row * DM + col;
                    *(GAS u32x4*)xp = w0; *(GAS u32x4*)(xp + 8) = w1;
                    if (fq == 0) *(GAS float*)(rowss + (size_t)row * 16 + u.pn * 4 + wc) = ss;
                } else {
                    float* op = (row < MP) ? outP + (size_t)row * DM + col : outS + (size_t)(row - MP) * DM + col;
#pragma unroll
                    for (int bj = 0; bj < 2; ++bj)
#pragma unroll
                        for (int n = 0; n < 2; ++n) *(GAS f32x4*)(op + 8 * bj + 4 * n) = acc[ai][bj][m][n];
                }
            }
    }
};

struct EpiPassA {
    static constexpr bool PERM = false, AFTER_DRAIN = true, HAS_INIT = false;
    const f32x2* a64; f32x2* hin; float* out; int layer;
    __device__ __forceinline__ void fused(const f32x4 (&acc)[2][2][4][2], const Unit& u, int wr, int wc, int fr, int fq, PG8_LAS unsigned char* lds, int wid, int lane) const {
        PG8_LAS float* S = (PG8_LAS float*)lds;
#pragma unroll
        for (int ai = 0; ai < 2; ++ai)
#pragma unroll
            for (int m = 0; m < 4; ++m) { const int r = ai * HALF + wr * 64 + m * 16 + fr;
#pragma unroll
                for (int n = 0; n < 2; ++n) *(PG8_LAS f32x4*)(S + r * 128 + wc * 32 + n * 16 + fq * 4) = acc[ai][0][m][n] + acc[ai][1][m][n]; }
        asm volatile("s_waitcnt lgkmcnt(0)" ::: "memory"); __builtin_amdgcn_s_barrier(); asm volatile("" ::: "memory");
        const int tid = wid * 64 + lane;
        if (tid < 256) {
            const int bl = tid >> 6, p = tid & 63, g = u.pm >> 2, b = (u.pm & 3) * 4 + bl;
            const f32x2 a = *(const GAS f32x2*)(a64 + g * 64 + p);
            float hr = 0.f, hi = 0.f;
            f32x2* hp = hin + ((size_t)(b * NCH) * NG + g) * NP + p;
            for (int c = 0; c < NCH; ++c) {
                const f32x2 s = *(const PG8_LAS f32x2*)(S + (bl * 64 + c) * 128 + 2 * p);
                *(GAS f32x2*)(hp + (size_t)c * NG * NP) = (f32x2){hr, hi};
                const float nr = a.x * hr - a.y * hi + s.x, ni = a.x * hi + a.y * hr + s.y;
                hr = nr; hi = ni;
            }
            const size_t o = ((size_t)(layer * NB + b) * NG + g) * NP + p;
            *(GAS float*)(out + O_RP + o) = hr; *(GAS float*)(out + O_IP + o) = hi;
        }
        asm volatile("s_waitcnt lgkmcnt(0)" ::: "memory"); __builtin_amdgcn_s_barrier(); asm volatile("" ::: "memory");
    }
};

template <class Epi, class Sched, class GP, bool ALIGN_EPI = false, bool SP2 = false>
__device__ __forceinline__ void gemm_phase(PG8_LAS unsigned char* lds, const GP& g, const Sched& S, const Epi& E) {
    int tid_ = threadIdx.x; asm volatile("" : "+v"(tid_));
    const int tid = tid_, wid = __builtin_amdgcn_readfirstlane(tid >> 6), lane = tid & 63, wr = wid >> 2, wc = wid & 3, fr = lane & 15, fq = lane >> 4;
    const int nt = g.nt();
    unsigned voffA[2], voffB[2];
#pragma unroll
    for (int i = 0; i < 2; ++i) { int R, C; stage_rc(tid * 16 + i * 8192, R, C); const int Rb = Epi::PERM ? ((R & ~31) + perm32(R & 31)) : R;
        voffA[i] = g.a_voff(R, C); voffB[i] = g.b_voff(Rb, C); }
    const size_t kstepA = g.a_kstep(), kstepB = g.b_kstep(), hstepA = g.a_hstep(), hstepB = g.b_hstep();
    const unsigned ldsw = (unsigned)wid * 1024u;
    const int aoff = lds_byte(wr * 64 + fr, fq * 8), boff = lds_byte(wc * 32 + fr, fq * 8);
#define PG8_SA(b, h) (((b) * 2 + (h)) * HTB)
#define PG8_SB(b, h) ((4 + (b) * 2 + (h)) * HTB)
#define PG8_STAGE(bufoff, gbase, voff) do { _Pragma("unroll") for (int _i = 0; _i < 2; ++_i) \
        __builtin_amdgcn_global_load_lds((const unsigned*)((const char*)(gbase) + (voff)[_i]), (PG8_LAS unsigned*)(lds + (bufoff) + ldsw + _i * 8192), 16, 0, 0); } while (0)
#define PG8_LDA(dst, b, h) do { _Pragma("unroll") for (int m = 0; m < 4; ++m) _Pragma("unroll") for (int k = 0; k < 2; ++k) dst[m][k] = *(const PG8_LAS bf16x8*)(lds + PG8_SA(b, h) + aoff + m * 2048 + k * 1024); } while (0)
#define PG8_LDB(dst, b, h) do { _Pragma("unroll") for (int n = 0; n < 2; ++n) _Pragma("unroll") for (int k = 0; k < 2; ++k) dst[n][k] = *(const PG8_LAS bf16x8*)(lds + PG8_SB(b, h) + boff + n * 2048 + k * 1024); } while (0)
#define PG8_MMA(ai, bj, At, Bt) do { __builtin_amdgcn_s_setprio(1); _Pragma("unroll") for (int m = 0; m < 4; ++m) _Pragma("unroll") for (int n = 0; n < 2; ++n) _Pragma("unroll") for (int k = 0; k < 2; ++k) \
        acc[ai][bj][m][n] = __builtin_amdgcn_mfma_f32_16x16x32_bf16(Bt[n][k], At[m][k], acc[ai][bj][m][n], 0, 0, 0); __builtin_amdgcn_s_setprio(0); } while (0)
#define PG8_WAIT_V(n) asm volatile("s_waitcnt vmcnt(" #n ")" ::: "memory")
#define PG8_WAIT_L(n) asm volatile("s_waitcnt lgkmcnt(" #n ")" ::: "memory")
#define PG8_BAR __builtin_amdgcn_s_barrier()
#define PG8_SCHED __builtin_amdgcn_sched_barrier(0)
    Unit cur, nxt; int ui = 0;
    if (!S.next(0, cur)) return;
    f32x4 acc[2][2][4][2];
    if constexpr (Epi::HAS_INIT) E.init(acc, cur, wr, wc, fr, fq);
    else {
#pragma unroll
    for (int a = 0; a < 2; ++a)
#pragma unroll
        for (int b = 0; b < 2; ++b)
#pragma unroll
            for (int m = 0; m < 4; ++m)
#pragma unroll
                for (int n = 0; n < 2; ++n) acc[a][b][m][n] = (f32x4){0.f, 0.f, 0.f, 0.f};
    }
    bf16x8 At[4][2], B0[2][2], B1[2][2];
    const char* cA = g.a_base(cur); const char* cB = g.b_base(cur);
    S.a_ready(cur);
    if constexpr (SP2) {
        PG8_STAGE(PG8_SB(0, 0), cB, voffB); PG8_STAGE(PG8_SB(0, 1), cB + hstepB, voffB); PG8_STAGE(PG8_SA(0, 0), cA, voffA); PG8_STAGE(PG8_SA(0, 1), cA + hstepA, voffA);
        if (wr == 1) PG8_BAR;
        PG8_WAIT_V(2); PG8_BAR;
        PG8_STAGE(PG8_SB(1, 0), cB + kstepB, voffB); PG8_STAGE(PG8_SA(1, 0), cA + kstepA, voffA); PG8_STAGE(PG8_SB(1, 1), cB + hstepB + kstepB, voffB);
        PG8_WAIT_V(6); PG8_BAR;
    } else {
        PG8_STAGE(PG8_SB(0, 0), cB, voffB); PG8_STAGE(PG8_SA(0, 0), cA, voffA); PG8_STAGE(PG8_SB(0, 1), cB + hstepB, voffB); PG8_STAGE(PG8_SA(0, 1), cA + hstepA, voffA);
        if (wr == 1) PG8_BAR;
        PG8_WAIT_V(4); PG8_BAR;
        PG8_STAGE(PG8_SB(1, 0), cB + kstepB, voffB); PG8_STAGE(PG8_SA(1, 0), cA + kstepA, voffA); PG8_STAGE(PG8_SB(1, 1), cB + hstepB + kstepB, voffB);
        PG8_WAIT_V(6); PG8_BAR;
    }
    for (;;) {
        const bool has_next = S.next(ui + 1, nxt);
        const char* nA = has_next ? g.a_base(nxt) : cA; const char* nB = has_next ? g.b_base(nxt) : cB;
        for (int t = 0; t < nt; t += 2) {
            const bool last = (t == nt - 2);
            const char* a1 = cA + (size_t)(t + 1) * kstepA;
            const char* a2 = last ? nA : cA + (size_t)(t + 2) * kstepA; const char* b2 = last ? nB : cB + (size_t)(t + 2) * kstepB;
            const char* a3 = a2 + kstepA; const char* b3 = b2 + kstepB;
            if (last && has_next) S.a_ready(nxt);
            if constexpr (SP2) {
            PG8_LDB(B0, 0, 0); PG8_LDB(B1, 0, 1); PG8_SCHED; PG8_LDA(At, 0, 0); PG8_STAGE(PG8_SA(1, 1), a1 + hstepA, voffA);
            PG8_WAIT_V(8); PG8_WAIT_L(0); PG8_BAR; PG8_MMA(0, 0, At, B0); PG8_MMA(0, 1, At, B1); PG8_BAR; PG8_SCHED;
            PG8_LDA(At, 0, 1); PG8_STAGE(PG8_SB(0, 0), b2, voffB); PG8_STAGE(PG8_SB(0, 1), b2 + hstepB, voffB); PG8_STAGE(PG8_SA(0, 0), a2, voffA);
            PG8_WAIT_V(8); PG8_WAIT_L(0); PG8_BAR; PG8_MMA(1, 0, At, B0); PG8_MMA(1, 1, At, B1); PG8_BAR; PG8_SCHED;
            PG8_LDB(B0, 1, 0); PG8_LDB(B1, 1, 1); PG8_SCHED; PG8_LDA(At, 1, 0); PG8_STAGE(PG8_SA(0, 1), a2 + hstepA, voffA);
            PG8_WAIT_V(8); PG8_WAIT_L(0); PG8_BAR; PG8_MMA(0, 0, At, B0); PG8_MMA(0, 1, At, B1); PG8_BAR; PG8_SCHED;
            PG8_LDA(At, 1, 1); PG8_STAGE(PG8_SB(1, 0), b3, voffB); PG8_STAGE(PG8_SB(1, 1), b3 + hstepB, voffB); PG8_STAGE(PG8_SA(1, 0), a3, voffA);
            PG8_WAIT_V(8); PG8_WAIT_L(0); PG8_BAR; PG8_MMA(1, 0, At, B0); PG8_MMA(1, 1, At, B1); PG8_BAR; PG8_SCHED;
            } else {
            PG8_LDB(B0, 0, 0); PG8_SCHED; PG8_LDA(At, 0, 0); PG8_STAGE(PG8_SA(1, 1), a1 + hstepA, voffA);
            PG8_WAIT_L(8); PG8_BAR; PG8_WAIT_L(0); PG8_MMA(0, 0, At, B0); PG8_BAR; PG8_SCHED;
            PG8_LDB(B1, 0, 1); PG8_STAGE(PG8_SB(0, 0), b2, voffB);
            PG8_BAR; PG8_WAIT_L(0); PG8_MMA(0, 1, At, B1); PG8_BAR;
            PG8_LDA(At, 0, 1); PG8_STAGE(PG8_SA(0, 0), a2, voffA);
            PG8_BAR; PG8_WAIT_L(0); PG8_MMA(1, 0, At, B0); PG8_BAR; PG8_SCHED;
            PG8_STAGE(PG8_SB(0, 1), b2 + hstepB, voffB);
            PG8_WAIT_V(6); PG8_BAR; PG8_MMA(1, 1, At, B1); PG8_BAR;
            PG8_LDB(B0, 1, 0); PG8_SCHED; PG8_LDA(At, 1, 0); PG8_STAGE(PG8_SA(0, 1), a2 + hstepA, voffA);
            PG8_WAIT_L(8); PG8_BAR; PG8_WAIT_L(0); PG8_MMA(0, 0, At, B0); PG8_BAR; PG8_SCHED;
            PG8_LDB(B1, 1, 1); PG8_STAGE(PG8_SB(1, 0), b3, voffB);
            PG8_BAR; PG8_WAIT_L(0); PG8_MMA(0, 1, At, B1); PG8_BAR;
            PG8_LDA(At, 1, 1); PG8_STAGE(PG8_SA(1, 0), a3, voffA);
            PG8_BAR; PG8_WAIT_L(0); PG8_MMA(1, 0, At, B0); PG8_BAR; PG8_SCHED;
            PG8_STAGE(PG8_SB(1, 1), b3 + hstepB, voffB);
            PG8_WAIT_V(6); PG8_BAR; PG8_MMA(1, 1, At, B1); PG8_BAR;
            }
        }
        if constexpr (ALIGN_EPI) { if (wr == 0) PG8_BAR; }
        if constexpr (!Epi::AFTER_DRAIN) { E(acc, cur, wr, wc, fr, fq); S.done(cur); }
        if (!has_next) break;
        if constexpr (Epi::HAS_INIT) E.init(acc, nxt, wr, wc, fr, fq);
        else {
#pragma unroll
        for (int a = 0; a < 2; ++a)
#pragma unroll
            for (int b = 0; b < 2; ++b)
#pragma unroll
                for (int m = 0; m < 4; ++m)
#pragma unroll
                    for (int n = 0; n < 2; ++n) acc[a][b][m][n] = (f32x4){0.f, 0.f, 0.f, 0.f};
        }
        cur = nxt; cA = nA; cB = nB; ++ui;
        if constexpr (ALIGN_EPI) { if (wr == 1) PG8_BAR; }
    }
    PG8_WAIT_V(0);
    if constexpr (!ALIGN_EPI) { if (wr == 0) PG8_BAR; }
    PG8_BAR;
    if constexpr (Epi::AFTER_DRAIN) { E.fused(acc, cur, wr, wc, fr, fq, lds, wid, lane); S.done(cur); }
#undef PG8_SA
#undef PG8_SB
#undef PG8_STAGE
#undef PG8_LDA
#undef PG8_LDB
#undef PG8_MMA
#undef PG8_WAIT_V
#undef PG8_WAIT_L
#undef PG8_BAR
#undef PG8_SCHED
}
}
struct InPtrs { const float* p[21]; };
typedef const float* fptr_t;
typedef __attribute__((address_space(4))) const fptr_t* kargp_t;
__device__ __forceinline__ int rowmap_inout(int col) {
    const int a = col & 255, wc = a >> 6, fq = (a >> 4) & 3, bj = (a >> 3) & 1, n = (a >> 2) & 1, i = a & 3;
    return (col & ~255) + bj * 128 + wc * 32 + n * 16 + fq * 4 + i;
}
__device__ __forceinline__ int rowmap_glu(int c) {
    const int bj = c >> 9, j = c & 511, pn = j >> 7, jj = j & 127, wc = jj >> 5, fq = (jj >> 3) & 3, n = (jj >> 2) & 1, i = jj & 3;
    return pn * 256 + bj * 128 + wc * 32 + n * 16 + fq * 4 + i;
}
__device__ __forceinline__ void p0_transpose_item(const float* W, int K, int N, bf16_t* WT, int glu, const float* gain, LAS float* scr, int item, int lane) {
    const int nblk = N / 32, kb = item / nblk, nb = item % nblk, k0 = 64 * kb, n0 = 32 * nb;
#pragma unroll 8
    for (int i = 0; i < 32; ++i) { const int kk = 2 * i + (lane >> 5); float w = W[(size_t)(k0 + kk) * N + n0 + (lane & 31)]; if (gain) w *= gain[k0 + kk]; scr[kk * 33 + (lane & 31)] = w; }
    asm volatile("s_waitcnt lgkmcnt(0)" ::: "memory");
    const int c = lane & 7;
#pragma unroll
    for (int j = 0; j < 4; ++j) { const int n = (lane >> 3) + 8 * j; const LAS float* s = scr + (8 * c) * 33 + n;
        u32x4 o; o.x = pk2(s[0 * 33], s[1 * 33]); o.y = pk2(s[2 * 33], s[3 * 33]); o.z = pk2(s[4 * 33], s[5 * 33]); o.w = pk2(s[6 * 33], s[7 * 33]);
        const int dr = glu ? rowmap_glu(n0 + n) : rowmap_inout(n0 + n);
        *(u32x4*)(WT + (size_t)dr * K + k0 + 8 * c) = o; }
    asm volatile("s_waitcnt lgkmcnt(0)" ::: "memory");
}
__device__ __forceinline__ float wave_sum(float v) {
#pragma unroll
    for (int o = 1; o < 64; o <<= 1) v += __shfl_xor(v, o);
    return v;
}
struct Disc { double abr, abi, fr, fi, dt, ar, ai; };
__device__ __forceinline__ Disc s5_disc(kargp_t in, int l, int g, int p) {
    Disc d; d.ar = (double)in[8][(l * NG + g) * NP + p]; d.ai = (double)in[9][(l * NG + g) * NP + p]; d.dt = exp((double)in[15][l * NG + g]);
    const double mag = exp(d.dt * d.ar); double s, c; sincos(d.dt * d.ai, &s, &c);
    d.abr = mag * c; d.abi = mag * s;
    const double den = d.ar * d.ar + d.ai * d.ai, nr = d.abr - 1.0;
    d.fr = (nr * d.ar + d.abi * d.ai) / den; d.fi = (d.abi * d.ar - nr * d.ai) / den;
    return d;
}
__device__ __forceinline__ int crow(int r, int hi) { return (r & 3) + 8 * (r >> 2) + 4 * hi; }

__device__ __forceinline__ void p0_prologue(unsigned char* ws, LAS unsigned char* lds, int vcu, int G, int tid) {
    const int lane = tid & 63, wave = tid >> 6;
    kargp_t in = (kargp_t)__builtin_amdgcn_kernarg_segment_ptr(); asm volatile("" : "+s"(in));
    LAS float* scr = (LAS float*)(lds + wave * 16384);
    const int gw = vcu * 8 + wave, NGW = G * 8;
    constexpr int I_IN = (DM / 64) * (DIN / 32), I_GLU = (DS / 64) * (2 * DS / 32), I_OUT = (DM / 64) * (DM / 32), I_L = I_IN + I_GLU + I_OUT;
    for (int it = gw; it < NL * I_L; it += NGW) {
        const int l = it / I_L; int r = it % I_L;
        if (r < I_IN) { p0_transpose_item(in[7] + (size_t)l * DM * DIN, DM, DIN, (bf16_t*)(ws + WS_WIN + l * WIN_L), 0, in[6] + l * DM, scr, r, lane); continue; } r -= I_IN;
        if (r < I_GLU) { p0_transpose_item(in[16] + (size_t)l * DS * 2 * DS, DS, 2 * DS, (bf16_t*)(ws + WS_WGLU + l * WGLU_L), 1, nullptr, scr, r, lane); continue; } r -= I_GLU;
        p0_transpose_item(in[20] + (size_t)l * DM * DM, DM, DM, (bf16_t*)(ws + WS_WOUT + l * WOUT_L), 0, nullptr, scr, r, lane);
    }
    asm volatile("" : "+s"(in), "+s"(ws));
    {
        bf16_t* XB = (bf16_t*)(ws + WS_XB); float* rowss = (float*)(ws + WS_ROWSS);
        for (int m = gw; m < MT; m += NGW) {
            const float* xr = (m < MP) ? in[0] + (size_t)m * DM : in[1] + (size_t)(m - MP) * DM;
            f32x4 v[4]; float s = 0.f;
#pragma unroll
            for (int j = 0; j < 4; ++j) { v[j] = *(const f32x4*)(xr + 4 * lane + 256 * j); s += (v[j].x * v[j].x + v[j].y * v[j].y) + (v[j].z * v[j].z + v[j].w * v[j].w); }
            s = wave_sum(s);
#pragma unroll
            for (int j = 0; j < 4; ++j) { u32x2 o; o.x = pk2(v[j].x, v[j].y); o.y = pk2(v[j].z, v[j].w); *(u32x2*)(XB + (size_t)m * DM + 4 * lane + 256 * j) = o; }
            if (lane < 16) rowss[(size_t)m * 16 + lane] = (lane == 0) ? s : 0.f;
        }
    }
    asm volatile("" : "+s"(in), "+s"(ws));
    const int gt = vcu * 512 + tid, NGT = G * 512;
    for (int it = gt; it < NL * NG * NP; it += NGT) {
        const int l = it / (NG * NP), g = (it / NP) % NG, p = it % NP;
        const Disc d = s5_disc(in, l, g, p);
        unsigned char* tb = ws + WS_TAB + l * TAB_L;
        ((f32x2*)(tb + T_AB))[g * NP + p] = (f32x2){(float)d.abr, (float)d.abi};
        const double m64 = exp(64.0 * d.dt * d.ar); double s, c; sincos(64.0 * d.dt * d.ai, &s, &c);
        ((f32x2*)(tb + T_A64))[g * NP + p] = (f32x2){(float)(m64 * c), (float)(m64 * s)};
    }
    asm volatile("" : "+s"(in), "+s"(ws));
    for (int it = gt; it < NL * NG * 8 * 64; it += NGT) {
        const int l = it / (NG * 512), g = (it / 512) % NG, cb = (it / 64) % 8, ln = it % 64;
        const int p = 16 * (cb >> 1) + (ln & 15), ri = cb & 1;
        const Disc d = s5_disc(in, l, g, p);
        unsigned short o[8];
#pragma unroll
        for (int j = 0; j < 8; ++j) { const int k = 8 * (ln >> 4) + j, h = k & 15;
            const double br = (double)in[10][((size_t)(l * NG + g) * NP + p) * NCHN + h], bi = (double)in[11][((size_t)(l * NG + g) * NP + p) * NCHN + h];
            const float val = (float)(ri ? (d.fr * bi + d.fi * br) : (d.fr * br - d.fi * bi));
            const unsigned hi = f2bf(val); const unsigned lo = f2bf(val - bf2f(hi));
            o[j] = (unsigned short)(k < 16 ? hi : lo); }
        u32x4 w; w.x = o[0] | (o[1] << 16); w.y = o[2] | (o[3] << 16); w.z = o[4] | (o[5] << 16); w.w = o[6] | (o[7] << 16);
        ((u32x4*)(ws + WS_TAB + l * TAB_L + T_BU))[(g * 8 + cb) * 64 + ln] = w;
    }
    asm volatile("" : "+s"(in), "+s"(ws));
    for (int it = gt; it < NL * NG * 5 * 64; it += NGT) {
        const int l = it / (NG * 320), g = (it / 320) % NG, kb = (it / 64) % 5, ln = it % 64, h = ln & 15;
        unsigned short o[8];
        if (kb == 4) { const float dv = in[14][(l * NG + g) * NCHN + h]; const unsigned hi = f2bf(dv), lo = f2bf(dv - bf2f(hi));
#pragma unroll
            for (int j = 0; j < 8; ++j) { const int k = 8 * (ln >> 4) + j; o[j] = (unsigned short)(((k & 15) == h) ? (k < 16 ? hi : lo) : 0u); }
            u32x4 w; w.x = o[0] | (o[1] << 16); w.y = o[2] | (o[3] << 16); w.z = o[4] | (o[5] << 16); w.w = o[6] | (o[7] << 16);
            ((u32x4*)(ws + WS_TAB + l * TAB_L + T_D))[g * 64 + ln] = w;
        } else {
#pragma unroll
            for (int j = 0; j < 8; ++j) { const int kk = 8 * (ln >> 4) + j, p = 16 * kb + (kk >> 1), ri = kk & 1;
                const size_t ci = ((size_t)(l * NG + g) * NCHN + h) * NP + p;
                const float val = ri ? -in[13][ci] : in[12][ci]; o[j] = (unsigned short)f2bf(val); }
            u32x4 w; w.x = o[0] | (o[1] << 16); w.y = o[2] | (o[3] << 16); w.z = o[4] | (o[5] << 16); w.w = o[6] | (o[7] << 16);
            ((u32x4*)(ws + WS_TAB + l * TAB_L + T_C))[(g * 4 + kb) * 64 + ln] = w;
        }
    }
    asm volatile("" : "+s"(in), "+s"(ws));
    for (int it = gt; it < NL * NG * NP * 64; it += NGT) {
        const int l = it / (NG * NP * 64), g = (it / (NP * 64)) % NG, p = (it / 64) % NP, s = it % 64;
        const Disc d = s5_disc(in, l, g, p);
        const double n = (double)(63 - s), mg = exp(n * d.dt * d.ar); double sn, cs; sincos(n * d.dt * d.ai, &sn, &cs);
        const double wr = mg * cs, wi = mg * sn;
        const double zr = wr * d.fr - wi * d.fi, zi = wr * d.fi + wi * d.fr;
        unsigned short orh[16], oih[16], orl[16], oil[16];
#pragma unroll
        for (int h = 0; h < 16; ++h) {
            const double br = (double)in[10][((size_t)(l * NG + g) * NP + p) * NCHN + h], bi = (double)in[11][((size_t)(l * NG + g) * NP + p) * NCHN + h];
            const float vr = (float)(zr * br - zi * bi), vi = (float)(zr * bi + zi * br);
            const unsigned hr = f2bf(vr), hi = f2bf(vi);
            orh[h] = (unsigned short)hr; oih[h] = (unsigned short)hi; orl[h] = (unsigned short)f2bf(vr - bf2f(hr)); oil[h] = (unsigned short)f2bf(vi - bf2f(hi));
        }
        bf16_t* pm = (bf16_t*)(ws + WS_PM + l * PM_L) + (size_t)g * 256 * 1024 + 16 * s;
#pragma unroll
        for (int q = 0; q < 2; ++q) {
            u32x4 a, b, c, e;
            a.x = orh[8*q] | (orh[8*q+1] << 16); a.y = orh[8*q+2] | (orh[8*q+3] << 16); a.z = orh[8*q+4] | (orh[8*q+5] << 16); a.w = orh[8*q+6] | (orh[8*q+7] << 16);
            b.x = oih[8*q] | (oih[8*q+1] << 16); b.y = oih[8*q+2] | (oih[8*q+3] << 16); b.z = oih[8*q+4] | (oih[8*q+5] << 16); b.w = oih[8*q+6] | (oih[8*q+7] << 16);
            c.x = orl[8*q] | (orl[8*q+1] << 16); c.y = orl[8*q+2] | (orl[8*q+3] << 16); c.z = orl[8*q+4] | (orl[8*q+5] << 16); c.w = orl[8*q+6] | (orl[8*q+7] << 16);
            e.x = oil[8*q] | (oil[8*q+1] << 16); e.y = oil[8*q+2] | (oil[8*q+3] << 16); e.z = oil[8*q+4] | (oil[8*q+5] << 16); e.w = oil[8*q+6] | (oil[8*q+7] << 16);
            *(u32x4*)(pm + (size_t)(2 * p) * 1024 + 8 * q) = a; *(u32x4*)(pm + (size_t)(2 * p + 1) * 1024 + 8 * q) = b;
            *(u32x4*)(pm + (size_t)(128 + 2 * p) * 1024 + 8 * q) = c; *(u32x4*)(pm + (size_t)(128 + 2 * p + 1) * 1024 + 8 * q) = e;
        }
    }
    asm volatile("" : "+s"(in), "+s"(ws));
    for (int it = gt; it < NL * NH * 256; it += NGT) {
        const int l = it / (NH * 256), h = (it / 256) % NH, i = it % 256;
        const float* tab = in[19] + (size_t)(l * NH + h) * NREL;
        int d = i - 63; d = d > 128 ? 128 : d;
        ((float*)(ws + WS_TAB + l * TAB_L + T_BIAS))[h * 256 + i] = (tab[d + 128] - tab[256]) * LOG2E;
    }
}
namespace att {
constexpr int BUFB = 65536, LV = 32768, LWS = 131072 + 4096, LEB = 131072 + 8192;
constexpr float THR = 8.0f;
__device__ __forceinline__ s16x4 vtr(const LAS unsigned char* p) { return __builtin_bit_cast(s16x4, __builtin_amdgcn_ds_read_tr16_b64_v4i16((LAS s16x4*)p)); }

struct Ctx { const GAS unsigned char* ws; const GAS float* cache_k; const GAS float* cache_v; int layer; };

__device__ __forceinline__ void unit(const Ctx& C, LAS unsigned char* lds, int type, int seq, int n, int hg, int tid, int mode = 0) {
    const int lane = tid & 63, wid = __builtin_amdgcn_readfirstlane(tid >> 6), r32 = lane & 31, hi = lane >> 5, hh = wid >> 1, qh = wid & 1, head = hg * 4 + hh;
    const GAS bf16_t* Q = (const GAS bf16_t*)(C.ws + WS_Q); const GAS bf16_t* K = (const GAS bf16_t*)(C.ws + WS_K); const GAS bf16_t* V = (const GAS bf16_t*)(C.ws + WS_V);
    const GAS bf16_t* SGA = (const GAS bf16_t*)(C.ws + WS_SGA); GAS bf16_t* MIX = (GAS bf16_t*)(C.ws + (mode ? WS_YG : WS_MIX));
    const long qrow0 = type == 0 ? (long)seq * SEQ + n * 64 + qh * 32 : (long)MP + seq * SSEQ;
    const bool wave_valid = (type == 0) || (qh == 0);
    const bool row_valid = (type == 0) || (qh == 0 && r32 < SSEQ);
    LAS float* wsf = (LAS float*)(lds + LWS) + wid * 64;
    LAS float* eb = (LAS float*)(lds + LEB) + hh * 256;
    const int jstart = (type == 0 && n < 8) ? 8 - n : 0;
    __syncthreads();
    if (qh == 0) { const f32x4 e = *(const GAS f32x4*)(C.ws + WS_TAB + (size_t)C.layer * TAB_L + T_BIAS + ((size_t)head * 256 + lane * 4) * 4); *(LAS f32x4*)(eb + lane * 4) = e; }
    bf16x8 qr[4];
#pragma unroll
    for (int d0 = 0; d0 < 4; ++d0) { qr[d0] = (bf16x8){0, 0, 0, 0, 0, 0, 0, 0}; if (row_valid) qr[d0] = *(const GAS bf16x8*)(Q + (qrow0 + r32) * 512 + head * 64 + d0 * 16 + hi * 8); }
    const long krow_base = (long)seq * SEQ + (long)(n - 8) * 64;
    const int koff = (8 * wid + (lane >> 3)) * 512 + hg * 256 + (((lane & 7) ^ ((lane >> 3) & 7)) * 8);
    const int voff = (16 * (wid & 3) + (lane >> 2)) * 512 + hg * 256 + (wid >> 2) * 32 + (lane & 3) * 8;
#define ATT_DMA(jj, buf) do { const GAS bf16_t* kp_ = K + (krow_base + (long)(jj) * 64) * 512 + koff; const GAS bf16_t* vp_ = V + (krow_base + (long)(jj) * 64) * 512 + voff; \
        _Pragma("unroll") for (int i_ = 0; i_ < 4; ++i_) { \
            __builtin_amdgcn_global_load_lds((const GAS unsigned*)(kp_ + i_ * 64), (LAS unsigned*)(lds + (buf) * BUFB + (wid + 8 * i_) * 1024), 16, 0, 0); \
            __builtin_amdgcn_global_load_lds((const GAS unsigned*)(vp_ + i_ * 64), (LAS unsigned*)(lds + (buf) * BUFB + LV + (wid + 8 * i_) * 1024), 16, 0, 0); } } while (0)
    if (type == 0 && !(mode & 1)) ATT_DMA(jstart, 0);
    float m_run = 0.f, l_run = 0.f; bool first = true; f32x16 o[2]; o[0] = f32x16{}; o[1] = f32x16{};
    int cur = 0;
    for (int j = jstart; j < 9; ++j, cur ^= 1) {
        if (type == 1) {
            LAS unsigned char* kb_ = lds + cur * BUFB; LAS unsigned char* vb_ = kb_ + LV;
            if (j == 8) {
                const long krow0 = (long)MP + seq * SSEQ;
#pragma unroll 1
                for (int i = 0; i < 4; ++i) {
                    const int idx = tid + 512 * i;
                    { const int row = idx & 63, ch = (idx >> 6) & 7, h4 = idx >> 9; u32x4 v = (u32x4){0u, 0u, 0u, 0u};
                      if (row < SSEQ) v = *(const GAS u32x4*)(K + (krow0 + row) * 512 + (hg * 4 + h4) * 64 + ch * 8);
                      *(LAS u32x4*)(kb_ + h4 * 8192 + row * 128 + ((ch ^ (row & 7)) * 16)) = v; }
                    { const int h4 = idx >> 9, e = idx & 511, w8 = e >> 6, ln = e & 63, row = 16 * (w8 & 3) + (ln >> 2), dh = w8 >> 2, c16 = ln & 3; u32x4 v = (u32x4){0u, 0u, 0u, 0u};
                      if (row < SSEQ) v = *(const GAS u32x4*)(V + (krow0 + row) * 512 + (hg * 4 + h4) * 64 + dh * 32 + c16 * 8);
                      *(LAS u32x4*)(vb_ + idx * 16) = v; }
                }
            } else {
                const GAS float* ck = C.cache_k + ((size_t)(C.layer * SBAT + seq) * PAST + 64 * j) * (NH * HD);
                const GAS float* cv = C.cache_v + ((size_t)(C.layer * SBAT + seq) * PAST + 64 * j) * (NH * HD);
#pragma unroll 1
                for (int i = 0; i < 4; ++i) {
                    const int idx = tid + 512 * i;
                    { const int row = idx & 63, ch = (idx >> 6) & 7, h4 = idx >> 9; const GAS float* p = ck + (size_t)row * (NH * HD) + (hg * 4 + h4) * 64 + ch * 8;
                      const f32x4 a = *(const GAS f32x4*)p, b = *(const GAS f32x4*)(p + 4);
                      *(LAS u32x4*)(kb_ + h4 * 8192 + row * 128 + ((ch ^ (row & 7)) * 16)) = (u32x4){pk2(a.x, a.y), pk2(a.z, a.w), pk2(b.x, b.y), pk2(b.z, b.w)}; }
                    { const int h4 = idx >> 9, e = idx & 511, w8 = e >> 6, ln = e & 63, row = 16 * (w8 & 3) + (ln >> 2), dh = w8 >> 2, c16 = ln & 3;
                      const GAS float* p = cv + (size_t)row * (NH * HD) + (hg * 4 + h4) * 64 + dh * 32 + c16 * 8;
                      const f32x4 a = *(const GAS f32x4*)p, b = *(const GAS f32x4*)(p + 4);
                      *(LAS u32x4*)(vb_ + idx * 16) = (u32x4){pk2(a.x, a.y), pk2(a.z, a.w), pk2(b.x, b.y), pk2(b.z, b.w)}; }
                }
            }
        }
        __syncthreads();
        if (type == 0 && j < 8 && !(mode & 1)) ATT_DMA(j + 1, cur ^ 1);
        if (!wave_valid || (mode & 4)) continue;
        const LAS unsigned char* kbuf = lds + cur * BUFB;
        f32x16 p0, p1;
        if (j >= 6) {
            const LAS float* ep = eb + (32 * qh + r32 + (575 - 64 * j) - 4 * hi - 63);
#pragma unroll
            for (int r = 0; r < 16; ++r) { const int off = (r & 3) + 8 * (r >> 2); p0[r] = ep[63 - off] - m_run; p1[r] = ep[31 - off] - m_run; }
            if (type == 1 && j == 8) {
#pragma unroll
                for (int r = 0; r < 16; ++r) { if (crow(r, hi) >= SSEQ) p0[r] = -1.0e30f; p1[r] = -1.0e30f; }
            }
        } else {
#pragma unroll
            for (int r = 0; r < 16; ++r) { p0[r] = -m_run; p1[r] = -m_run; }
        }
        const LAS unsigned char* kb = kbuf + hh * 8192 + r32 * 128;
#pragma unroll
        for (int d0 = 0; d0 < 4; ++d0) {
            const int co = ((2 * d0 + hi) ^ (r32 & 7)) * 16;
            const bf16x8 k0 = *(const LAS bf16x8*)(kb + co), k1 = *(const LAS bf16x8*)(kb + 4096 + co);
            p0 = __builtin_amdgcn_mfma_f32_32x32x16_bf16(k0, qr[d0], p0, 0, 0, 0);
            p1 = __builtin_amdgcn_mfma_f32_32x32x16_bf16(k1, qr[d0], p1, 0, 0, 0);
        }
        if (!(mode & 2)) {
        float rm = fmaxf(p0[0], p1[0]);
#pragma unroll
        for (int r = 1; r < 16; ++r) rm = fmaxf(rm, fmaxf(p0[r], p1[r]));
        rm = fmaxf(rm, __shfl_xor(rm, 32));
        if (first) {
            first = false; m_run = rm;
#pragma unroll
            for (int r = 0; r < 16; ++r) { p0[r] -= rm; p1[r] -= rm; }
        } else if (__any(rm > THR)) {
            const float dl = fmaxf(rm, 0.f), alpha = __builtin_amdgcn_exp2f(-dl);
            m_run += dl; l_run *= alpha;
#pragma unroll
            for (int r = 0; r < 16; ++r) { p0[r] -= dl; p1[r] -= dl; }
            if (hi == 0) wsf[r32] = alpha;
            asm volatile("s_waitcnt lgkmcnt(0)" ::: "memory");
#pragma unroll
            for (int r = 0; r < 16; ++r) { const float al = wsf[crow(r, hi)]; o[0][r] *= al; o[1][r] *= al; }
        }
        float ls = 0.f;
#pragma unroll
        for (int r = 0; r < 16; ++r) { p0[r] = __builtin_amdgcn_exp2f(p0[r]); p1[r] = __builtin_amdgcn_exp2f(p1[r]); ls += p0[r] + p1[r]; }
        l_run += ls;
        }
        u32x4 pw[4];
#pragma unroll
        for (int q4 = 0; q4 < 4; ++q4) { pw[0][q4] = pk2(p0[2 * q4], p0[2 * q4 + 1]); pw[1][q4] = pk2(p0[8 + 2 * q4], p0[8 + 2 * q4 + 1]); pw[2][q4] = pk2(p1[2 * q4], p1[2 * q4 + 1]); pw[3][q4] = pk2(p1[8 + 2 * q4], p1[8 + 2 * q4 + 1]); }
        const int vb = (int)(unsigned)(uintptr_t)(kbuf + LV + hh * 8192 + ((lane >> 4) & 1) * 32 + (lane & 3) * 8 + (4 * hi + ((lane & 15) >> 2)) * 64);
#pragma unroll
        for (int d0 = 0; d0 < 2; ++d0) {
            s16x4 lo[4], hv[4];
#pragma unroll
            for (int ks = 0; ks < 4; ++ks) {
                asm volatile("ds_read_b64_tr_b16 %0, %1 offset:%c2" : "=&v"(lo[ks]) : "v"(vb), "i"(d0 * 4096 + ks * 1024) : "memory");
                asm volatile("ds_read_b64_tr_b16 %0, %1 offset:%c2" : "=&v"(hv[ks]) : "v"(vb), "i"(d0 * 4096 + ks * 1024 + 512) : "memory");
            }
            asm volatile("s_waitcnt lgkmcnt(0)" ::: "memory"); __builtin_amdgcn_sched_barrier(0);
#pragma unroll
            for (int ks = 0; ks < 4; ++ks) {
                const bf16x8 vf = (bf16x8){lo[ks][0], lo[ks][1], lo[ks][2], lo[ks][3], hv[ks][0], hv[ks][1], hv[ks][2], hv[ks][3]};
                o[d0] = __builtin_amdgcn_mfma_f32_32x32x16_bf16(__builtin_bit_cast(bf16x8, pw[ks]), vf, o[d0], 0, 0, 0);
            }
        }
    }
#undef ATT_DMA
    __syncthreads();
    if (wave_valid) {
        const float lt = l_run + __shfl_xor(l_run, 32);
        if (hi == 0) wsf[32 + r32] = lt;
        asm volatile("s_waitcnt lgkmcnt(0)" ::: "memory");
        LAS bf16_t* stg = (LAS bf16_t*)lds + wid * 2048;
#pragma unroll
        for (int r = 0; r < 16; ++r) { const int orow = crow(r, hi); const float rl = 1.0f / wsf[32 + orow];
            stg[orow * 64 + r32] = (bf16_t)f2bf(o[0][r] * rl); stg[orow * 64 + 32 + r32] = (bf16_t)f2bf(o[1][r] * rl); }
        asm volatile("s_waitcnt lgkmcnt(0)" ::: "memory");
#pragma unroll
        for (int i = 0; i < 4; ++i) { const int row = i * 8 + (lane >> 3), ch = lane & 7;
            if (type == 0 || row < SSEQ) {
                const u32x4 ov = *(const LAS u32x4*)(stg + row * 64 + ch * 8);
                const u32x4 gv = *(const GAS u32x4*)(SGA + (qrow0 + row) * 512 + head * 64 + ch * 8);
                u32x4 w;
#pragma unroll
                for (int c = 0; c < 4; ++c) { const float a0 = bf2f(ov[c] & 0xffffu) * bf2f(gv[c] & 0xffffu), a1 = bf2f(ov[c] >> 16) * bf2f(gv[c] >> 16); w[c] = pk2(a0, a1); }
                *(GAS u32x4*)(MIX + (qrow0 + row) * 1024 + 512 + head * 64 + ch * 8) = w; } }
    }
}

__device__ __forceinline__ void phase(const Ctx& C, LAS unsigned char* lds, GAS unsigned* qctr, int bx, int tid, int max_units = 1 << 30) {
    LAS unsigned* bc = (LAS unsigned*)(lds + 131072 + 1024);
    for (int dq = 0; dq < 8; ++dq) {
        const int x = (bx + dq) & 7;
        for (;;) {
            __syncthreads();
            if (tid == 0) bc[0] = __hip_atomic_fetch_add(qctr + x * 64, 1u, __ATOMIC_RELAXED, __HIP_MEMORY_SCOPE_AGENT);
            __syncthreads();
            const unsigned idx = bc[0];
            if (idx >= 256u) break;
            const int k = (int)idx, sq = 4 * x + (k >> 6);
            unit(C, lds, 0, sq >> 1, k & 63, sq & 1, tid);
            if (--max_units <= 0) return;
        }
    }
#if defined(PROBE_MODE)
    if (bx == 0) for (int rep = 0; rep < 64; ++rep) unit(C, lds, 0, 0, 16 + (rep & 31), 0, tid, PROBE_MODE);
#endif
}
}
namespace s5 {
constexpr int HKB = 1040;
constexpr int WLDS = 8192 + 4 * HKB;
static_assert(8 * WLDS <= 131072, "s5 lds");
struct Ctx { const GAS unsigned char* ws; const GAS float* st_re; const GAS float* st_im; GAS float* out; int layer; };

__device__ __forceinline__ void phase(const Ctx& C, LAS unsigned char* lds, int blk, int nblk, int u_lo, int u_hi, int tid) {
    const int lane = tid & 63, wave = __builtin_amdgcn_readfirstlane(tid >> 6), fr = lane & 15, fq = lane >> 4;
    LAS unsigned char* wl = lds + wave * WLDS; LAS unsigned char* hb = wl + 8192;
    const int gw = blk * 8 + wave, NGW = nblk * 8;
    if (NGW % NG != 0) return;
    const int g = gw & (NG - 1);
    const GAS unsigned char* tb = C.ws + WS_TAB + (size_t)C.layer * TAB_L;
    const GAS bf16_t* Ug = (const GAS bf16_t*)(C.ws + WS_U) + (size_t)g * MT * 16; GAS bf16_t* YG = (GAS bf16_t*)(C.ws + WS_YG);
    bf16x8 bu[8], cm[4], dmat;
#pragma unroll
    for (int cb = 0; cb < 8; ++cb) bu[cb] = *(const GAS bf16x8*)(tb + T_BU + ((size_t)(g * 8 + cb) * 64 + lane) * 16);
#pragma unroll
    for (int kb = 0; kb < 4; ++kb) cm[kb] = *(const GAS bf16x8*)(tb + T_C + ((size_t)(g * 4 + kb) * 64 + lane) * 16);
    dmat = *(const GAS bf16x8*)(tb + T_D + ((size_t)g * 64 + lane) * 16);
    const f32x2 ab = *(const GAS f32x2*)(tb + T_AB + ((size_t)g * 64 + lane) * 8);
    const int NU = u_hi;
    bf16x8 ua[4], un[4]; f32x2 h0, hn; h0 = (f32x2){0.f, 0.f};
#pragma unroll
    for (int rb = 0; rb < 4; ++rb) ua[rb] = (bf16x8){0, 0, 0, 0, 0, 0, 0, 0};
#define S5_LOAD(u_, UA, H0) do { if ((u_) < NU) { \
        if ((u_) < NB * NCH * NG) { const long r0_ = (long)((u_) >> 11) * SEQ + (((u_) >> 5) & 63) * 64; \
            _Pragma("unroll") for (int rb = 0; rb < 4; ++rb) UA[rb] = *(const GAS bf16x8*)(Ug + (r0_ + rb * 16 + fr) * 16 + (fq & 1) * 8); \
            H0 = *(const GAS f32x2*)(C.ws + WS_HIN + ((((size_t)((u_) >> 11) * NCH + (((u_) >> 5) & 63)) * NG + g) * NP + lane) * 8); } \
        else { const int s_ = ((u_) - NB * NCH * NG) >> 5; UA[0] = *(const GAS bf16x8*)(Ug + ((long)MP + s_ * SSEQ + fr) * 16 + (fq & 1) * 8); \
            const size_t si_ = ((size_t)(C.layer * SBAT + s_) * NG + g) * NP + lane; H0 = (f32x2){C.st_re[si_], C.st_im[si_]}; } } } while (0)
    S5_LOAD(u_lo + gw, ua, h0);
    for (int u = u_lo + gw; u < NU; u += NGW) {
        const int u2 = u + NGW;
        S5_LOAD(u2, un, hn);
        const bool samp = u >= NB * NCH * NG;
        const long row0 = samp ? (long)MP + ((u - NB * NCH * NG) >> 5) * SSEQ : (long)(u >> 11) * SEQ + ((u >> 5) & 63) * 64;
        const int nrb = samp ? 1 : 4;
        float hr = h0.x, hi = h0.y;
#pragma unroll
        for (int rb = 0; rb < 4; ++rb) {
            if (rb < nrb) {
                const bf16x8 uu = ua[rb];
#pragma unroll
                for (int j = 0; j < 4; ++j) {
                    const f32x4 z = {0.f, 0.f, 0.f, 0.f};
                    const f32x4 re = __builtin_amdgcn_mfma_f32_16x16x32_bf16(uu, bu[2 * j], z, 0, 0, 0);
                    const f32x4 im = __builtin_amdgcn_mfma_f32_16x16x32_bf16(uu, bu[2 * j + 1], z, 0, 0, 0);
#pragma unroll
                    for (int r = 0; r < 4; ++r) *(LAS f32x2*)(wl + (4 * fq + r) * 512 + (16 * j + fr) * 8) = (f32x2){re[r], im[r]};
                }
#pragma unroll
                for (int t = 0; t < 16; ++t) {
                    const f32x2 b = *(const LAS f32x2*)(wl + t * 512 + lane * 8);
                    const float nr = ab.x * hr - ab.y * hi + b.x, ni = ab.x * hi + ab.y * hr + b.y;
                    hr = nr; hi = ni;
                    *(LAS unsigned*)(hb + (lane >> 4) * HKB + t * 64 + (lane & 15) * 4) = pk2(hr, hi);
                }
                f32x4 y = {0.f, 0.f, 0.f, 0.f};
#pragma unroll
                for (int kb = 0; kb < 4; ++kb) { const bf16x8 ha = *(const LAS bf16x8*)(hb + kb * HKB + fr * 64 + fq * 16); y = __builtin_amdgcn_mfma_f32_16x16x32_bf16(ha, cm[kb], y, 0, 0, 0); }
                y = __builtin_amdgcn_mfma_f32_16x16x32_bf16(uu, dmat, y, 0, 0, 0);
#pragma unroll
                for (int r = 0; r < 4; ++r) YG[(row0 + rb * 16 + 4 * fq + r) * 512 + g * 16 + fr] = (bf16_t)f2bf(gelu_tanh(y[r]));
            }
        }
        if (samp) { const size_t o = ((size_t)(C.layer * SBAT + ((u - NB * NCH * NG) >> 5)) * NG + g) * NP + lane; C.out[O_RS + o] = hr; C.out[O_IS + o] = hi; }
#pragma unroll
        for (int rb = 0; rb < 4; ++rb) ua[rb] = un[rb];
        h0 = hn;
    }
#undef S5_LOAD
}
}
typedef GAS unsigned gu32;
#define XB_TMO      128
#define XB_XCNT(j)  (256  + 64 * (j))
#define XB_XSUB(j)  (1280 + 64 * (j))
#define XB_XGEN(j)  (2304 + 64 * (j))
#define XB_TOP      3328
#define XB_TOPGEN   3392
#define XCD_BAR_WORDS 3456
#define XB_SPIN_CAP (1u << 18)

__device__ __forceinline__ unsigned xb_ld(unsigned* p)              { return __hip_atomic_load(p, __ATOMIC_RELAXED, __HIP_MEMORY_SCOPE_AGENT); }
__device__ __forceinline__ unsigned xb_add(unsigned* p, unsigned v) { return __hip_atomic_fetch_add(p, v, __ATOMIC_RELAXED, __HIP_MEMORY_SCOPE_AGENT); }
__device__ __forceinline__ unsigned xb_xcc_id() { return (unsigned)__builtin_amdgcn_s_getreg((3 << 11) | 20) & 0xFu; }
#define XB_SPIN(cond, bar) do { unsigned _sp = 0; while (cond) { __builtin_amdgcn_s_sleep(1); \
    if ((++_sp & 255u) == 0u) { if (xb_ld(&(bar)[XB_TMO])) break; if (_sp > XB_SPIN_CAP) { atomicAdd(&(bar)[XB_TMO], 1u); break; } } } } while (0)

struct XcdBarrier {
    unsigned* bar; unsigned x;
    volatile LAS unsigned* st;
};

__device__ __forceinline__ XcdBarrier xcd_barrier_post(unsigned* bar, volatile LAS unsigned* st) {
    XcdBarrier b; b.bar = bar; b.x = xb_xcc_id(); b.st = st;
    if (threadIdx.x == 0) (void)xb_add(&bar[XB_XCNT(b.x)], 1u);
    return b;
}
__device__ __forceinline__ void xcd_barrier_complete(unsigned* bar, unsigned x, unsigned& nloc, unsigned& nx) {
    const unsigned G = gridDim.x * gridDim.y * gridDim.z;
    unsigned sum, cnt, mine, sp = 0u;
    for (;;) {
        sum = 0u; cnt = 0u; mine = 0u;
#pragma unroll
        for (unsigned j = 0; j < 16; ++j) { const unsigned c = xb_ld(&bar[XB_XCNT(j)]); sum += c; cnt += (c > 0u) ? 1u : 0u; mine = (j == x) ? c : mine; }
        if (sum == G) break;
        __builtin_amdgcn_s_sleep(1);
        if ((++sp & 255u) == 0u) { if (xb_ld(&bar[XB_TMO])) break; if (sp > XB_SPIN_CAP) { atomicAdd(&bar[XB_TMO], 1u); break; } }
    }
    nloc = mine > 0u ? mine : 1u; nx = cnt > 0u ? cnt : 1u;
}

__device__ __forceinline__ void xcd_barrier(const XcdBarrier& b) {
    asm volatile("s_waitcnt vmcnt(0)" ::: "memory");
    __syncthreads();
    if (threadIdx.x == 0) {
        unsigned* bar = b.bar;
        __builtin_amdgcn_s_waitcnt(0);
        unsigned nloc = b.st[0], nx = b.st[1];
        if (nloc == 0u) { xcd_barrier_complete(bar, b.x, nloc, nx); b.st[0] = nloc; b.st[1] = nx; }
        const unsigned old = xb_add(&bar[XB_XSUB(b.x)], 1u);
        const unsigned gen = old / nloc;
        if (old + 1u == (gen + 1u) * nloc) {
            __builtin_amdgcn_fence(__ATOMIC_RELEASE, "agent");
            asm volatile("s_waitcnt vmcnt(0)" ::: "memory");
            const unsigned og = xb_add(&bar[XB_TOP], 1u);
            const unsigned tg = og / nx;
            if (og + 1u == (tg + 1u) * nx) xb_add(&bar[XB_TOPGEN], 1u);
            else XB_SPIN(xb_ld(&bar[XB_TOPGEN]) == tg, bar);
            __builtin_amdgcn_fence(__ATOMIC_ACQUIRE, "agent");
            xb_add(&bar[XB_XGEN(b.x)], 1u);
            asm volatile("s_waitcnt vmcnt(0)" ::: "memory");
        } else {
            XB_SPIN(xb_ld(&bar[XB_XGEN(b.x)]) == gen, bar);
            __builtin_amdgcn_fence(__ATOMIC_ACQUIRE, "agent");
            asm volatile("s_waitcnt vmcnt(0)" ::: "memory");
        }
    }
    __syncthreads();
}

#ifndef PHMASK
#define PHMASK 0xFF
#endif
constexpr int LDS_BYTES = 147456;
constexpr int NPHASE = 1 + 5 * NL;
struct Args { InPtrs in; float* out; unsigned char* ws; int ph_lo, ph_hi; };

constexpr int NTEAM = 24;
constexpr int CW_TEAM = 4096;
constexpr int NTEAM2 = 64;
__device__ __forceinline__ void team_arrive(gu32* ctr) {
    asm volatile("s_waitcnt vmcnt(0)" ::: "memory");
    __syncthreads();
    if (threadIdx.x == 0) {
        __builtin_amdgcn_fence(__ATOMIC_RELEASE, "agent");
        asm volatile("s_waitcnt vmcnt(0)" ::: "memory");
        (void)__hip_atomic_fetch_add(ctr, 1u, __ATOMIC_RELAXED, __HIP_MEMORY_SCOPE_AGENT);
    }
}
__device__ __forceinline__ void team_wait(gu32* ctr, unsigned n) {
    if (threadIdx.x == 0) {
        unsigned sp = 0;
        while (__hip_atomic_load(ctr, __ATOMIC_RELAXED, __HIP_MEMORY_SCOPE_AGENT) < n) { __builtin_amdgcn_s_sleep(2); if (++sp > (1u << 22)) break; }
        __builtin_amdgcn_fence(__ATOMIC_ACQUIRE, "agent");
        asm volatile("s_waitcnt vmcnt(0)" ::: "memory");
    }
    __syncthreads();
}
#ifndef PROBE_PH
#define PROBE_PH -1
#endif
#ifndef N_CG_SYNC
#define N_CG_SYNC 1
#endif
template <bool COOP>
__global__ void __launch_bounds__(512, 2) fwd(Args a) {
    extern __shared__ __attribute__((aligned(16))) unsigned char lds_raw[];
    LAS unsigned char* lds = (LAS unsigned char*)lds_raw;
    const int tid = threadIdx.x, G = gridDim.x, bx = blockIdx.x;
    const int vcu = (G % 8 == 0) ? (bx % 8) * (G / 8) + bx / 8 : bx;
    volatile LAS unsigned* MISC = (volatile LAS unsigned*)(lds + 131072 + 2048);
    XcdBarrier bar; bar.bar = nullptr; bar.x = 0; bar.st = nullptr;
    unsigned long long t_probe = 0, t_last = 0;
    if constexpr (COOP) {
        if (tid < 16) MISC[tid] = 0u;
        if (tid < 8) ((volatile LAS unsigned*)(lds + 131072 + 3072))[tid] = 0u;
        __syncthreads();
        bar = xcd_barrier_post((unsigned*)(a.ws + WS_CTL) + CW_BAR, MISC + 8);
        if (PROBE_PH >= 0) t_last = __builtin_amdgcn_s_memrealtime();
    }
    int seam = 0;
#define SEAM() do { if constexpr (COOP) { if (seam < N_CG_SYNC) cg::this_grid().sync(); else xcd_barrier(bar); ++seam; } } while (0)
#define STAMP(ph_) do { if constexpr (COOP) { if (PROBE_PH >= 0) { const unsigned long long now_ = __builtin_amdgcn_s_memrealtime(); if ((ph_) == PROBE_PH) t_probe = now_ - t_last; t_last = now_; } } } while (0)
    if (a.ph_lo == 0) {
        unsigned char* ws = a.ws; asm volatile("" : "+s"(ws));
        p0_prologue(ws, lds, vcu, G, tid);
        if (a.ph_hi > 1) SEAM();
        STAMP(0);
    }
    for (int ph = (a.ph_lo < 1 ? 1 : a.ph_lo); ph < a.ph_hi; ++ph) {
        unsigned char* ws = a.ws; float* out = a.out; asm volatile("" : "+s"(ws), "+s"(out));
        {
            const int l = (ph - 1) / 5, k = (ph - 1) % 5;
#ifndef KMASK
#define KMASK 31
#endif
            if (k == 0 && (KMASK & 1)) {
                pg8::GemmStd g{(const char*)(ws + WS_XB), (const char*)(ws + WS_WIN + l * WIN_L), DM};
                pg8::StaticOrder S; S.init(MP, DIN, G, bx);
                pg8::EpiInProj E{(const float*)(ws + WS_ROWSS), ws, a.in.p[17] + l * HD, a.in.p[18] + l * HD, out, l};
                pg8::gemm_phase<pg8::EpiInProj, pg8::StaticOrder, pg8::GemmStd, true, true>(lds, g, S, E);
            } else if (k == 1 && (KMASK & 2)) {
                if (bx < NTEAM2) {
                    gu32* tbar = (gu32*)(ws + WS_CTL) + CW_TEAM + l * 256;
                    int tid_ = threadIdx.x; asm volatile("" : "+v"(tid_));
                    att::Ctx C{(const GAS unsigned char*)ws, (const GAS float*)a.in.p[2], (const GAS float*)a.in.p[3], l};
                    if (bx < 24) {
                        pg8::GemmStd g{(const char*)(ws + WS_XB), (const char*)(ws + WS_WIN + l * WIN_L), DM};
                        pg8::StaticOrder S; S.init_team(DIN, 24, MP / 256, bx);
                        pg8::EpiInProj E{(const float*)(ws + WS_ROWSS), ws, a.in.p[17] + l * HD, a.in.p[18] + l * HD, out, l};
                        pg8::gemm_phase<pg8::EpiInProj, pg8::StaticOrder, pg8::GemmStd, true, true>(lds, g, S, E);
                        team_arrive(tbar);
                    } else {
                        att::phase(C, lds, (GAS unsigned*)(ws + WS_CTL) + CW_QUEUE + l * 512, bx, tid_, 1);
                    }
                    team_wait(tbar, 24);
                    att::unit(C, lds, 1, bx >> 1, 0, bx & 1, tid_);
                    __syncthreads();
                    {   s5::Ctx C5{(const GAS unsigned char*)ws, (const GAS float*)a.in.p[4], (const GAS float*)a.in.p[5], (GAS float*)out, l};
                        s5::phase(C5, lds, bx, NTEAM2, NB * NCH * NG, NB * NCH * NG + SBAT * NG, tid_); }
                    team_arrive(tbar + 64);
                    if (bx < 8) {
                        team_wait(tbar + 64, NTEAM2);
                        {   pg8::GemmStd g{(const char*)(ws + WS_YG), (const char*)(ws + WS_WGLU + l * WGLU_L), DS};
                            pg8::StaticOrder S; S.init_team(2 * DS, 8, MP / 256, bx);
                            pg8::EpiGlu E{(const bf16_t*)(ws + WS_SG), (bf16_t*)(ws + WS_MIX)};
                            pg8::gemm_phase<pg8::EpiGlu, pg8::StaticOrder, pg8::GemmStd, true, true>(lds, g, S, E); }
                        team_arrive(tbar + 128);
                        team_wait(tbar + 128, 8);
                        {   pg8::GemmStd g{(const char*)(ws + WS_MIX), (const char*)(ws + WS_WOUT + l * WOUT_L), DM};
                            pg8::StaticOrder S; S.init_team(DM, 8, MP / 256, bx);
                            pg8::EpiOut E{a.in.p[0], a.in.p[1], out + O_YP, out + O_YS, (bf16_t*)(ws + WS_XB), (float*)(ws + WS_ROWSS), l == 0 ? 1 : 0};
                            pg8::gemm_phase<pg8::EpiOut, pg8::StaticOrder, pg8::GemmStd, true, true>(lds, g, S, E); }
                    }
                    __syncthreads();
                }
                {
                    pg8::GemmPassA g{(const char*)(ws + WS_U), (const char*)(ws + WS_PM + l * PM_L)};
                    pg8::OneUnitOrder S{NG * 4, bx - 128};
                    pg8::EpiPassA E{(const f32x2*)(ws + WS_TAB + l * TAB_L + T_A64), (f32x2*)(ws + WS_HIN), out, l};
                    pg8::gemm_phase<pg8::EpiPassA, pg8::OneUnitOrder, pg8::GemmPassA, false, true>(lds, g, S, E);
                }
                int tid_ = threadIdx.x; asm volatile("" : "+v"(tid_));
                att::Ctx C{(const GAS unsigned char*)ws, (const GAS float*)a.in.p[2], (const GAS float*)a.in.p[3], l};
                att::phase(C, lds, (GAS unsigned*)(ws + WS_CTL) + CW_QUEUE + l * 512, bx, tid_);
            } else if (k == 2 && (KMASK & 4)) {
                int tid_ = threadIdx.x; asm volatile("" : "+v"(tid_));
                s5::Ctx C{(const GAS unsigned char*)ws, (const GAS float*)a.in.p[4], (const GAS float*)a.in.p[5], (GAS float*)out, l};
                s5::phase(C, lds, vcu, G, 0, NB * NCH * NG, tid_);
            } else if (k == 3 && (KMASK & 8)) {
                pg8::GemmStd g{(const char*)(ws + WS_YG), (const char*)(ws + WS_WGLU + l * WGLU_L), DS};
                pg8::StaticOrder S; S.init(MP, 2 * DS, G, bx);
                pg8::EpiGlu E{(const bf16_t*)(ws + WS_SG), (bf16_t*)(ws + WS_MIX)};
                pg8::gemm_phase<pg8::EpiGlu, pg8::StaticOrder, pg8::GemmStd, true, true>(lds, g, S, E);
            } else if (KMASK & 16) {
                pg8::GemmStd g{(const char*)(ws + WS_MIX), (const char*)(ws + WS_WOUT + l * WOUT_L), DM};
                pg8::StaticOrder S; S.init(MP, DM, G, bx);
                pg8::EpiOut E{a.in.p[0], a.in.p[1], out + O_YP, out + O_YS, (bf16_t*)(ws + WS_XB), (float*)(ws + WS_ROWSS), l == 0 ? 1 : 0};
                pg8::gemm_phase<pg8::EpiOut, pg8::StaticOrder, pg8::GemmStd, true, true>(lds, g, S, E);
            }
        }
        if (ph + 1 < a.ph_hi) SEAM();
        else if (PROBE_PH >= 0) { if constexpr (COOP) xcd_barrier(bar); }
        STAMP(ph);
    }
#if defined(PROBE_REGION)
    if constexpr (COOP) { __syncthreads(); if (bx == 0 && tid == 0) { const unsigned long long d_ = ((volatile LAS unsigned long long*)(lds + 131072 + 3072))[0]; const unsigned long long t0 = __builtin_amdgcn_s_memrealtime(); while (__builtin_amdgcn_s_memrealtime() - t0 < d_) __builtin_amdgcn_s_sleep(8); } }
#endif
    if constexpr (COOP) { if (PROBE_PH >= 0 && bx == 0 && tid == 0) { const unsigned long long t0 = __builtin_amdgcn_s_memrealtime(); while (__builtin_amdgcn_s_memrealtime() - t0 < t_probe) __builtin_amdgcn_s_sleep(8); } }
#undef SEAM
#undef STAMP
}

#ifndef MK_ONE_LAUNCH
#define MK_ONE_LAUNCH 1
#endif
extern "C" void kernel_launch(void* const* d_in, const int* in_sizes, int n_in, void* d_out, int out_size, void* d_ws, size_t ws_size, hipStream_t stream) {
    static int grid = 0;
    if (grid == 0) {
        if (n_in != 21 || (size_t)out_size != O_END || ws_size < WS_END) { fprintf(stderr, "kernel_launch: unexpected shapes (n_in %d out %d ws %zu)\n", n_in, out_size, ws_size); grid = -1; return; }
        int dev = 0, cus = 0, per_cu = 0;
        (void)hipGetDevice(&dev); (void)hipDeviceGetAttribute(&cus, hipDeviceAttributeMultiprocessorCount, dev);
        (void)hipFuncSetAttribute((const void*)fwd<false>, hipFuncAttributeMaxDynamicSharedMemorySize, LDS_BYTES);
        (void)hipFuncSetAttribute((const void*)fwd<true>, hipFuncAttributeMaxDynamicSharedMemorySize, LDS_BYTES);
        (void)hipOccupancyMaxActiveBlocksPerMultiprocessor(&per_cu, (const void*)fwd<true>, 512, LDS_BYTES);
        if (per_cu < 1) { fprintf(stderr, "kernel_launch: occupancy query says %d blocks per CU\n", per_cu); per_cu = 1; }
        (void)hipGetLastError();
        grid = cus;
    }
    if (grid < 0) return;
    (void)hipMemsetAsync((char*)d_ws + WS_CTL, 0, CTL_BYTES, stream);
    Args a{};
    for (int i = 0; i < 21; ++i) a.in.p[i] = (const float*)d_in[i];
    a.out = (float*)d_out; a.ws = (unsigned char*)d_ws;
#if MK_ONE_LAUNCH
    a.ph_lo = 0; a.ph_hi = NPHASE;
    void* args[] = {&a};
    hipError_t e = hipLaunchCooperativeKernel((const void*)fwd<true>, dim3(grid), dim3(512), args, LDS_BYTES, stream);
    if (e != hipSuccess) fprintf(stderr, "cooperative launch failed: %s (grid %d)\n", hipGetErrorString(e), grid);
#else
    for (int ph = 0; ph < NPHASE; ++ph) { a.ph_lo = ph; a.ph_hi = ph + 1; hipLaunchKernelGGL(fwd<false>, dim3(grid), dim3(512), LDS_BYTES, stream, a); }
#endif
}
```
